# Optimizing an MI355X kernel written in HIP

```python
import math
import jax, jax.numpy as jnp
from jax import lax
import numpy as np

D_MODEL = 2048
BATCH = 4
SEQ = 4096
DEPTH = 1

A_HEADS = 8
A_HEAD_DIM = 128
A_WIDTH = A_HEADS * A_HEAD_DIM
MOBA_BLOCK = 256
MOBA_TOPK = 3
MOBA_Q_CHUNK = 32
B_Q_HEADS = 16
B_KV_HEADS = 2
B_HEAD_DIM = 64
B_WIDTH = B_Q_HEADS * B_HEAD_DIM
B_KV_WIDTH = B_KV_HEADS * B_HEAD_DIM
WINDOW = 128
NUM_BUCKETS = 32
MAX_DISTANCE = 128
MAX_EXACT = NUM_BUCKETS // 2
N_BIAS_HEADS = A_HEADS + B_Q_HEADS
D_FF = -(-(8 * D_MODEL) // (3 * 256)) * 256
IN_SPLITS = [A_WIDTH, 2 * A_WIDTH, 3 * A_WIDTH,
             3 * A_WIDTH + B_WIDTH,
             3 * A_WIDTH + B_WIDTH + B_KV_WIDTH,
             3 * A_WIDTH + B_WIDTH + 2 * B_KV_WIDTH,
             3 * A_WIDTH + B_WIDTH + 2 * B_KV_WIDTH + D_MODEL]
IN_WIDTH = 3 * A_WIDTH + B_WIDTH + 2 * B_KV_WIDTH + 2 * D_MODEL
EPS = 1e-6
NEG = -1e30

kernel_name = "hybrid_moba_swa_sink_t5bias_block"


def rmsnorm(x, g):
    xf = x.astype(jnp.float32)
    y = xf * lax.rsqrt(jnp.mean(xf * xf, axis=-1, keepdims=True) + EPS)
    return y.astype(x.dtype) * g.astype(x.dtype)


def t5_bucket(dist):
    n = jnp.maximum(dist, 0)
    nf = jnp.maximum(n, 1).astype(jnp.float32)
    large = MAX_EXACT + (jnp.log(nf / MAX_EXACT) / math.log(MAX_DISTANCE / MAX_EXACT)
                         * (NUM_BUCKETS - MAX_EXACT)).astype(jnp.int32)
    large = jnp.minimum(large, NUM_BUCKETS - 1)
    return jnp.where(n < MAX_EXACT, n, large)


def moba_attention(q, k, v, table_a):
    B_, H, S, Dh = q.shape
    L = MOBA_BLOCK
    nb = -(-S // L)
    s_pad = nb * L
    pad = ((0, 0), (0, 0), (0, s_pad - S), (0, 0))
    kb = jnp.pad(k, pad).reshape(B_, H, nb, L, Dh)
    vb = jnp.pad(v, pad).reshape(B_, H, nb, L, Dh)
    kmean = jnp.mean(kb.astype(jnp.float32), axis=3)
    gate = jnp.einsum('bhsd,bhnd->bhsn', q.astype(jnp.float32), kmean)
    q_blk = jnp.arange(S) // L
    past = jnp.arange(nb)[None, :] < q_blk[:, None]
    gate = jnp.where(past, gate, NEG)
    k_sel = min(MOBA_TOPK, nb)
    _, sel = lax.top_k(gate, k_sel)
    sel_valid = sel < q_blk[:, None]

    C = MOBA_Q_CHUNK
    n_chunks = S // C
    q_ch = q.reshape(B_, H, n_chunks, C, Dh).transpose(2, 0, 1, 3, 4)
    sel_ch = sel.reshape(B_, H, n_chunks, C, k_sel).transpose(2, 0, 1, 3, 4)
    val_ch = sel_valid.reshape(B_, H, n_chunks, C, k_sel).transpose(2, 0, 1, 3, 4)
    b_ix = jnp.arange(B_)[:, None, None, None]
    h_ix = jnp.arange(H)[None, :, None, None]
    offs = jnp.arange(L)
    scale = Dh ** -0.5

    def chunk(args):
        c, qc, selc, validc = args
        q0 = c * C
        qpos = q0 + jnp.arange(C)
        own = q0 // L
        k_g = kb[b_ix, h_ix, selc]
        v_g = vb[b_ix, h_ix, selc]
        k_own = lax.dynamic_index_in_dim(kb, own, axis=2, keepdims=False)
        v_own = lax.dynamic_index_in_dim(vb, own, axis=2, keepdims=False)
        s_sel = jnp.einsum('bhcd,bhcnld->bhcnl', qc, k_g).reshape(B_, H, C, k_sel * L)
        s_own = jnp.einsum('bhcd,bhld->bhcl', qc, k_own)
        kpos_sel = (selc[..., None] * L + offs).reshape(B_, H, C, k_sel * L)
        dist_sel = qpos[None, None, :, None] - kpos_sel
        bias_sel = table_a[t5_bucket(dist_sel), h_ix].astype(jnp.float32)
        dist_own = qpos[:, None] - (own * L + offs)[None, :]
        bias_own = table_a[t5_bucket(dist_own)].transpose(2, 0, 1).astype(jnp.float32)
        mask_sel = jnp.broadcast_to(validc[..., None], (B_, H, C, k_sel, L)).reshape(B_, H, C, k_sel * L)
        mask_own = dist_own >= 0
        l_sel = jnp.where(mask_sel, s_sel.astype(jnp.float32) * scale + bias_sel, NEG)
        l_own = jnp.where(mask_own, s_own.astype(jnp.float32) * scale + bias_own, NEG)
        p = jax.nn.softmax(jnp.concatenate([l_sel, l_own], axis=-1), axis=-1).astype(v.dtype)
        p_sel = p[..., :k_sel * L].reshape(B_, H, C, k_sel, L)
        p_own = p[..., k_sel * L:]
        return (jnp.einsum('bhcnl,bhcnld->bhcd', p_sel, v_g)
                + jnp.einsum('bhcl,bhld->bhcd', p_own, v_own))

    out = lax.map(chunk, (jnp.arange(n_chunks), q_ch, sel_ch, val_ch))
    return out.transpose(1, 2, 0, 3, 4).reshape(B_, H, S, Dh)


def swa_sink_attention(q, k, v, sinks, table_b):
    B_, Hq, S, Dh = q.shape
    Hkv = k.shape[1]
    G = Hq // Hkv
    W = WINDOW
    nq = S // W
    qb = q.reshape(B_, Hkv, G, nq, W, Dh)
    pad = ((0, 0), (0, 0), (W, 0), (0, 0))
    kp = jnp.pad(k, pad).reshape(B_, Hkv, nq + 1, W, Dh)
    vp = jnp.pad(v, pad).reshape(B_, Hkv, nq + 1, W, Dh)
    kband = jnp.concatenate([kp[:, :, :-1], kp[:, :, 1:]], axis=3)
    vband = jnp.concatenate([vp[:, :, :-1], vp[:, :, 1:]], axis=3)
    s = jnp.einsum('bkgnqd,bknld->bkgnql', qb, kband).astype(jnp.float32) * (Dh ** -0.5)
    qpos = jnp.arange(nq)[:, None] * W + jnp.arange(W)[None, :]
    kpos = jnp.arange(nq)[:, None] * W - W + jnp.arange(2 * W)[None, :]
    dist = qpos[:, :, None] - kpos[:, None, :]
    mask = (dist >= 0) & (dist < W) & (kpos[:, None, :] >= 0)
    bias = table_b[t5_bucket(dist)].astype(jnp.float32)
    bias = bias.transpose(3, 0, 1, 2).reshape(Hkv, G, nq, W, 2 * W)
    logits = jnp.where(mask, s + bias, NEG)
    sink = jnp.broadcast_to(sinks.astype(jnp.float32).reshape(1, Hkv, G, 1, 1, 1),
                            (B_, Hkv, G, nq, W, 1))
    p = jax.nn.softmax(jnp.concatenate([logits, sink], axis=-1), axis=-1)[..., :-1]
    out = jnp.einsum('bkgnql,bknld->bkgnqd', p.astype(v.dtype), vband)
    return out.reshape(B_, Hq, S, Dh)


def setup_inputs(seed: int = 0) -> dict:
    key = jax.random.key(seed)
    ks = jax.random.split(key, 16)

    def nrm(k, shape, scale):
        return jax.random.normal(k, shape, jnp.float32) * scale

    return {
        "x": nrm(ks[0], (BATCH, SEQ, D_MODEL), 1.0),
        "norm1_g": 1.0 + nrm(ks[1], (DEPTH, D_MODEL), 0.02),
        "w_in": nrm(ks[2], (DEPTH, D_MODEL, IN_WIDTH), D_MODEL ** -0.5),
        "q_norm_a": 1.0 + nrm(ks[3], (DEPTH, A_HEAD_DIM), 0.02),
        "k_norm_a": 1.0 + nrm(ks[4], (DEPTH, A_HEAD_DIM), 0.02),
        "q_norm_b": 1.0 + nrm(ks[5], (DEPTH, B_HEAD_DIM), 0.02),
        "k_norm_b": 1.0 + nrm(ks[6], (DEPTH, B_HEAD_DIM), 0.02),
        "rel_bias": nrm(ks[7], (NUM_BUCKETS, N_BIAS_HEADS), 0.5),
        "sinks": nrm(ks[8], (DEPTH, B_Q_HEADS), 0.5),
        "w_branch_a": nrm(ks[9], (DEPTH, A_WIDTH, D_MODEL), A_WIDTH ** -0.5),
        "w_branch_b": nrm(ks[10], (DEPTH, B_WIDTH, D_MODEL), B_WIDTH ** -0.5),
        "w_out": nrm(ks[11], (DEPTH, D_MODEL, D_MODEL), D_MODEL ** -0.5),
        "norm2_g": 1.0 + nrm(ks[12], (DEPTH, D_MODEL), 0.02),
        "w_gate_up": nrm(ks[13], (DEPTH, D_MODEL, 2 * D_FF), D_MODEL ** -0.5),
        "w_down": nrm(ks[14], (DEPTH, D_FF, D_MODEL), D_FF ** -0.5),
    }


def reference(x, norm1_g, w_in, q_norm_a, k_norm_a, q_norm_b, k_norm_b, rel_bias, sinks,
              w_branch_a, w_branch_b, w_out, norm2_g, w_gate_up, w_down):
    B_, S, _ = x.shape
    table_a = rel_bias[:, :A_HEADS]
    table_b = rel_bias[:, A_HEADS:]

    def heads(t, n, d):
        return t.reshape(B_, S, n, d).transpose(0, 2, 1, 3)

    for l in range(DEPTH):
        h = rmsnorm(x, norm1_g[l])
        proj = h @ w_in[l].astype(h.dtype)
        qa, ka, va, qb, kb, vb, ga, gb = jnp.split(proj, IN_SPLITS, axis=-1)
        qa = rmsnorm(heads(qa, A_HEADS, A_HEAD_DIM), q_norm_a[l])
        ka = rmsnorm(heads(ka, A_HEADS, A_HEAD_DIM), k_norm_a[l])
        va = heads(va, A_HEADS, A_HEAD_DIM)
        qb = rmsnorm(heads(qb, B_Q_HEADS, B_HEAD_DIM), q_norm_b[l])
        kb = rmsnorm(heads(kb, B_KV_HEADS, B_HEAD_DIM), k_norm_b[l])
        vb = heads(vb, B_KV_HEADS, B_HEAD_DIM)
        ya = moba_attention(qa, ka, va, table_a).transpose(0, 2, 1, 3).reshape(B_, S, A_WIDTH)
        yb = swa_sink_attention(qb, kb, vb, sinks[l], table_b).transpose(0, 2, 1, 3).reshape(B_, S, B_WIDTH)
        merged = (jax.nn.sigmoid(ga) * (ya @ w_branch_a[l].astype(ya.dtype))
                  + jax.nn.sigmoid(gb) * (yb @ w_branch_b[l].astype(yb.dtype)))
        x = x + merged @ w_out[l].astype(merged.dtype)
        h2 = rmsnorm(x, norm2_g[l])
        g, u = jnp.split(h2 @ w_gate_up[l].astype(h2.dtype), 2, axis=-1)
        x = x + (jax.nn.silu(g) * u) @ w_down[l].astype(h2.dtype)
    return x
```

```cpp
#include <hip/hip_runtime.h>
#include <hip/hip_cooperative_groups.h>
#include <cstdio>
#include <cstdint>
namespace cg = cooperative_groups;

#ifndef DEFER_W
#define DEFER_W 1
#endif
#ifndef P4_FP8
#define P4_FP8 1
#endif
#ifndef MK_N_LAUNCHES
#define MK_N_LAUNCHES 1
#endif

constexpr int DM = 2048, BATCH = 4, SEQ = 4096, M = BATCH * SEQ;
constexpr int AH = 8, AD = 128, AW = 1024, LBLK = 256, NBLK = SEQ / LBLK;
constexpr int BHQ = 16, BKVH = 2, BD = 64, BW = 1024, BKW = 128, WIN = 128;
constexpr int DFF = 5632, INW = 8448, NBH = 24;
constexpr float EPS = 1e-6f, LOG2E = 1.4426950408889634f;
constexpr int TBLW = 132;

constexpr size_t MiB = 1u << 20;
constexpr size_t WS_CTL = 0, WS_TBL = 4096, WS_GNT = 24576  , WS_BAR = 32768, WS_KMEAN = 65536;
constexpr size_t WS_ROWSS = 1 * MiB;
constexpr size_t WS_WIN = 3 * MiB  , WS_WIN8 = 20 * MiB  , WS_WAB = 36 * MiB, WS_WOUT = 44 * MiB, WS_WGU = 52 * MiB, WS_WDN = 96 * MiB;
constexpr size_t WS_RA = 118 * MiB;
constexpr size_t WS_RB = 182 * MiB;
constexpr size_t WS_QA = 246 * MiB, WS_KA = 278 * MiB, WS_VA = 310 * MiB, WS_QB = 342 * MiB, WS_KB = 374 * MiB, WS_VB = 378 * MiB;
constexpr size_t WS_G = 382 * MiB;
constexpr size_t WS_ACT = 246 * MiB;
constexpr size_t WS_END = 510 * MiB;
static_assert(WS_ACT + (size_t)M * DFF * 2 <= WS_END && WS_G + (size_t)M * 4096 * 2 <= WS_END, "ws map");

__device__ __forceinline__ int fresh_lane() { int l = (int)__builtin_amdgcn_mbcnt_hi(~0u, __builtin_amdgcn_mbcnt_lo(~0u, 0u)); asm volatile("" : "+v"(l)); return l; }
namespace pg8 {
#define PG8_LAS __attribute__((address_space(3)))
typedef unsigned short bf16_t;
typedef short bf16x8 __attribute__((ext_vector_type(8)));
typedef float f32x4 __attribute__((ext_vector_type(4)));
typedef float f32x2 __attribute__((ext_vector_type(2)));
typedef unsigned u32x4 __attribute__((ext_vector_type(4)));
typedef unsigned u32x2 __attribute__((ext_vector_type(2)));
constexpr int BM = 256, BK = 64, HALF = 128, HTB = HALF * BK * 2, STAGE_BYTES = 8 * HTB, NXCD = 8, WGM = 8;

__host__ __device__ __forceinline__ int lds_byte(int r, int c) { const int st = (r >> 4) * 2 + (c >> 5), rr = r & 15, cc = c & 31, ob = rr * 64 + cc * 2; return st * 1024 + (ob ^ (((ob >> 9) & 1) << 5)); }
__host__ __device__ __forceinline__ void stage_rc(int b, int& R, int& C) { const int st = b / 1024, sb = b % 1024, swz = sb ^ (((sb >> 9) & 1) << 5); R = (st >> 1) * 16 + swz / 64; C = (st & 1) * 32 + (swz % 64) / 2; }
__host__ __device__ __forceinline__ int perm32(int rho) { const int n = rho >> 4, i = rho & 15; return 8 * (i >> 2) + 4 * n + (i & 3); }

struct Unit { int pm, pn; };
struct Gemm { const bf16_t* A; const bf16_t* Bt; int M, N, K; };

struct StaticOrder {
    int nM, nN, nwg, G, c;
    __host__ __device__ void init(int M_, int N_, int G_, int c_) { nM = M_ / BM; nN = N_ / BM; nwg = nM * nN; G = G_; c = c_; }
    __host__ __device__ bool next(int i, Unit& u) const {
        const long L = (long)i * G + c; if (L >= nwg) return false;
        int wgid = (int)L; { const int q = nwg / NXCD, r = nwg % NXCD, xcd = wgid % NXCD, off = wgid / NXCD; wgid = (xcd < r ? xcd * (q + 1) : r * (q + 1) + (xcd - r) * q) + off; }
        const int nig = WGM * nN, gid = wgid / nig, fm = gid * WGM, gsz = (nM - fm) < WGM ? (nM - fm) : WGM;
        u.pm = fm + ((wgid % nig) % gsz); u.pn = (wgid % nig) / gsz; return true;
    }
};

__device__ __forceinline__ unsigned cvt_pk_bf16(float lo, float hi) {
    typedef __bf16 bf16x2_t __attribute__((ext_vector_type(2)));
    f32x2 v = {lo, hi}; bf16x2_t b = __builtin_convertvector(v, bf16x2_t); return __builtin_bit_cast(unsigned, b);
}
__device__ __forceinline__ unsigned pk4_fp8(float a, float b, float c, float d) { int p = __builtin_amdgcn_cvt_pk_fp8_f32(a, b, 0, false); return (unsigned)__builtin_amdgcn_cvt_pk_fp8_f32(c, d, p, true); }
__device__ __forceinline__ float bf_lo(unsigned w) { return __uint_as_float(w << 16); }
__device__ __forceinline__ float bf_hi(unsigned w) { return __uint_as_float(w & 0xffff0000u); }
__device__ __forceinline__ float sigmoid_neg_exp(float x) { return __builtin_amdgcn_exp2f(-x * LOG2E); }

struct EpiProj {
    static constexpr bool PERM = true, HAS_MID = false, DUP_EPI = false;
    bf16_t *QA, *KA, *VA, *QB, *KB, *VB, *G; int pn_off; float sc;
    __device__ __forceinline__ void mid(f32x4 (&)[2][2][4][2], const Unit&, int, int, int, int) const {}
    __device__ __forceinline__ void operator()(const f32x4 (&acc)[2][2][4][2], const Unit& u, int wr, int wc, int fr, int fq) const {
        const int row0 = u.pm * BM + wr * 64 + fr, cw = wc * 32 + 8 * fq, pn = pn_off == 0 ? (u.pn < 11 ? u.pn : u.pn + 1) : (u.pn == 0 ? 11 : u.pn + 16);
#pragma unroll
        for (int bj = 0; bj < 2; ++bj) {
            bf16_t* base; int ld, col;
            if (pn < 4) { base = QA; ld = 1024; col = pn * 256 + bj * 128 + cw; }
            else if (pn < 8) { base = KA; ld = 1024; col = (pn - 4) * 256 + bj * 128 + cw; }
            else if (pn < 12) { base = VA; ld = 1024; col = (pn - 8) * 256 + bj * 128 + cw; }
            else if (pn < 16) { base = QB; ld = 1024; col = (pn - 12) * 256 + bj * 128 + cw; }
            else if (pn == 16) { base = bj ? VB : KB; ld = 128; col = cw; }
            else { base = G; ld = 2048  ; col = (pn - 17) * 256 + bj * 128 + cw; }
#pragma unroll
            for (int ai = 0; ai < 2; ++ai)
#pragma unroll
                for (int m = 0; m < 4; ++m) {
                    const f32x4 v0 = acc[ai][bj][m][0] * sc, v1 = acc[ai][bj][m][1] * sc;
                    if (pn >= 17) {
                        u32x2 w; w.x = pk4_fp8(v0[0], v0[1], v0[2], v0[3]); w.y = pk4_fp8(v1[0], v1[1], v1[2], v1[3]);
                        *(u32x2*)((unsigned char*)base + (size_t)(row0 + ai * HALF + m * 16) * 4096 + col) = w;
                    } else {
                    u32x4 w; w.x = cvt_pk_bf16(v0[0], v0[1]); w.y = cvt_pk_bf16(v0[2], v0[3]); w.z = cvt_pk_bf16(v1[0], v1[1]); w.w = cvt_pk_bf16(v1[2], v1[3]);
                    *(u32x4*)(base + (size_t)(row0 + ai * HALF + m * 16) * ld + col) = w; }
                }
        }
    }
};

struct EpiProjNorm {
    static constexpr bool PERM = true, HAS_MID = false, DUP_EPI = false;
    unsigned char* ws; PG8_LAS unsigned char* xl;
    __device__ __forceinline__ void mid(f32x4 (&)[2][2][4][2], const Unit&, int, int, int, int) const {}
    __device__ __forceinline__ void operator()(f32x4 (&acc)[2][2][4][2], const Unit& u, int wr, int wc, int fr, int fq) const {
        const int gt = u.pn < 11 ? u.pn : u.pn + 1;
        int row0 = u.pm * BM + wr * 64 + fr, cw = wc * 32 + 8 * fq;
        asm volatile("" : "+v"(row0), "+v"(cw));
        if (gt >= 8 && gt <= 10) {
#pragma unroll
            for (int bj = 0; bj < 2; ++bj)
#pragma unroll
                for (int ai = 0; ai < 2; ++ai)
#pragma unroll
                    for (int m = 0; m < 4; ++m) { const f32x4 v0 = acc[ai][bj][m][0], v1 = acc[ai][bj][m][1];
                        u32x4 w; w.x = cvt_pk_bf16(v0[0], v0[1]); w.y = cvt_pk_bf16(v0[2], v0[3]); w.z = cvt_pk_bf16(v1[0], v1[1]); w.w = cvt_pk_bf16(v1[2], v1[3]);
                        *(u32x4*)((bf16_t*)(ws + WS_VA) + (size_t)(row0 + ai * HALF + m * 16) * 1024 + (gt - 8) * 256 + bj * HALF + cw) = w; }
            return;
        }
        PG8_LAS float* P = (PG8_LAS float*)xl;
        PG8_LAS float* KM = (PG8_LAS float*)(xl + 8192);
        const bool h64 = gt >= 12;
#pragma unroll
        for (int ai = 0; ai < 2; ++ai)
#pragma unroll
            for (int m = 0; m < 4; ++m)
#pragma unroll
                for (int bj = 0; bj < 2; ++bj) { const f32x4 a = acc[ai][bj][m][0], b = acc[ai][bj][m][1];
                    float ss = ((a[0] * a[0] + a[1] * a[1]) + (a[2] * a[2] + a[3] * a[3])) + ((b[0] * b[0] + b[1] * b[1]) + (b[2] * b[2] + b[3] * b[3]));
                    ss += __shfl_xor(ss, 16); ss += __shfl_xor(ss, 32);
                    if (fq == 0) P[((ai * HALF + wr * 64 + m * 16 + fr) * 2 + bj) * 4 + wc] = ss; }
        asm volatile("s_waitcnt lgkmcnt(0)" ::: "memory"); __builtin_amdgcn_s_barrier(); asm volatile("" ::: "memory");
        const float* gn = (const float*)(ws + WS_GNT) + (gt < 4 ? 0 : gt < 8 ? 128 : gt < 16 ? 256 : 384);
        const float qs = gt < 4 ? 0.08838834764831845f * LOG2E : (gt >= 12 && gt < 16) ? 0.125f * LOG2E : 1.f;
        const int dcol = h64 ? (cw & 63) : cw;
        const f32x4 g0 = *(const f32x4*)(gn + dcol) * qs, g1 = *(const f32x4*)(gn + dcol + 4) * qs;
        const float inv_hd = h64 ? (1.f / 64.f) : (1.f / 128.f);
        f32x4 cs[2][2];
#pragma unroll
        for (int bj = 0; bj < 2; ++bj) { cs[bj][0] = (f32x4){0.f, 0.f, 0.f, 0.f}; cs[bj][1] = (f32x4){0.f, 0.f, 0.f, 0.f}; }
#pragma unroll
        for (int bj = 0; bj < 2; ++bj) {
            size_t boff; int ld, col; bool nrm = true;
            if (gt < 4) { boff = WS_QA; ld = 1024; col = gt * 256 + bj * HALF + cw; }
            else if (gt < 8) { boff = WS_KA; ld = 1024; col = (gt - 4) * 256 + bj * HALF + cw; }
            else if (gt < 16) { boff = WS_QB; ld = 1024; col = (gt - 12) * 256 + bj * HALF + cw; }
            else { boff = bj ? WS_VB : WS_KB; ld = 128; col = cw; nrm = (bj == 0); }
            bf16_t* base = (bf16_t*)(ws + boff);
#pragma unroll
            for (int ai = 0; ai < 2; ++ai)
#pragma unroll
                for (int m = 0; m < 4; ++m) {
                    const int r = ai * HALF + wr * 64 + m * 16 + fr;
                    const f32x4 p = *(const PG8_LAS f32x4*)(P + (r * 2 + bj) * 4);
                    const float ss = h64 ? ((wc & 2) ? (p[2] + p[3]) : (p[0] + p[1])) : ((p[0] + p[1]) + (p[2] + p[3]));
                    const float rs = nrm ? __builtin_amdgcn_rsqf(ss * inv_hd + EPS) : 1.f;
                    f32x4 v0 = acc[ai][bj][m][0], v1 = acc[ai][bj][m][1];
                    if (nrm) { v0 = v0 * rs * g0; v1 = v1 * rs * g1; }
                    cs[bj][0] += v0; cs[bj][1] += v1; asm volatile("" : "+v"(cs[bj][0]), "+v"(cs[bj][1]));
                    u32x4 w; w.x = cvt_pk_bf16(v0[0], v0[1]); w.y = cvt_pk_bf16(v0[2], v0[3]); w.z = cvt_pk_bf16(v1[0], v1[1]); w.w = cvt_pk_bf16(v1[2], v1[3]);
                    *(u32x4*)(base + (size_t)(row0 + ai * HALF + m * 16) * ld + col) = w;
                    asm volatile("" ::: "memory");
                }
        }
        if (gt >= 4 && gt < 8) {
#pragma unroll
            for (int bj = 0; bj < 2; ++bj)
#pragma unroll
                for (int n = 0; n < 2; ++n)
#pragma unroll
                    for (int i = 0; i < 4; ++i) { float c = cs[bj][n][i]; c += __shfl_xor(c, 1); c += __shfl_xor(c, 2); c += __shfl_xor(c, 4); c += __shfl_xor(c, 8); cs[bj][n][i] = c; }
            if (fr == 0) {
#pragma unroll
                for (int bj = 0; bj < 2; ++bj) { *(PG8_LAS f32x4*)(KM + wr * 256 + bj * HALF + cw) = cs[bj][0]; *(PG8_LAS f32x4*)(KM + wr * 256 + bj * HALF + cw + 4) = cs[bj][1]; }
            }
            asm volatile("s_waitcnt lgkmcnt(0)" ::: "memory"); __builtin_amdgcn_s_barrier(); asm volatile("" ::: "memory");
            const int t = (wr * 4 + wc) * 64 + fq * 16 + fr;
            if (t < 256) { const int b = u.pm / NBLK, nb = u.pm % NBLK, hh = (gt - 4) * 2 + (t >> 7), d = t & 127;
                ((float*)(ws + WS_KMEAN))[(size_t)((b * AH + hh) * NBLK + nb) * AD + d] = (KM[t] + KM[256 + t]) * (1.f / LBLK); }
        }
    }
};
struct EpiMerge {
    static constexpr bool PERM = true, HAS_MID = true, DUP_EPI = false;
    static constexpr int MID_T = P4_FP8 ? 8 : 16;
    const bf16_t* G; bf16_t* OUT;
    __device__ __forceinline__ void mid(f32x4 (&acc)[2][2][4][2], const Unit& u, int wr, int wc, int fr, int fq) const {
        int row0 = u.pm * BM + wr * 64 + fr, col0 = u.pn * BM + wc * 32 + 8 * fq;
        asm volatile("" : "+v"(row0), "+v"(col0));
#pragma unroll
        for (int ai = 0; ai < 2; ++ai)
#pragma unroll
            for (int m = 0; m < 4; ++m)
#pragma unroll
                for (int bj = 0; bj < 2; ++bj) {
                    const unsigned char* gp = (const unsigned char*)G + (size_t)(row0 + ai * HALF + m * 16) * 4096 + col0 + bj * HALF;
                    const u32x2 ga = *(const u32x2*)gp, gb = *(const u32x2*)(gp + 2048);
                    float r[8];
#pragma unroll
                    for (int i = 0; i < 2; ++i) {
                        const f32x2 a01 = __builtin_amdgcn_cvt_pk_f32_fp8((int)ga[i], false), a23 = __builtin_amdgcn_cvt_pk_f32_fp8((int)ga[i], true);
                        const f32x2 b01 = __builtin_amdgcn_cvt_pk_f32_fp8((int)gb[i], false), b23 = __builtin_amdgcn_cvt_pk_f32_fp8((int)gb[i], true);
                        r[4 * i + 0] = (1.f + sigmoid_neg_exp(b01[0])) * __builtin_amdgcn_rcpf(1.f + sigmoid_neg_exp(a01[0]));
                        r[4 * i + 1] = (1.f + sigmoid_neg_exp(b01[1])) * __builtin_amdgcn_rcpf(1.f + sigmoid_neg_exp(a01[1]));
                        r[4 * i + 2] = (1.f + sigmoid_neg_exp(b23[0])) * __builtin_amdgcn_rcpf(1.f + sigmoid_neg_exp(a23[0]));
                        r[4 * i + 3] = (1.f + sigmoid_neg_exp(b23[1])) * __builtin_amdgcn_rcpf(1.f + sigmoid_neg_exp(a23[1]));
                    }
                    f32x4& a0 = acc[ai][bj][m][0]; f32x4& a1 = acc[ai][bj][m][1];
                    a0[0] *= r[0]; a0[1] *= r[1]; a0[2] *= r[2]; a0[3] *= r[3]; a1[0] *= r[4]; a1[1] *= r[5]; a1[2] *= r[6]; a1[3] *= r[7];
                    if (bj) asm volatile("" ::: "memory");
                }
    }
    __device__ __forceinline__ void operator()(const f32x4 (&acc)[2][2][4][2], const Unit& u, int wr, int wc, int fr, int fq) const {
        int row0 = u.pm * BM + wr * 64 + fr, col0 = u.pn * BM + wc * 32 + 8 * fq;
        asm volatile("" : "+v"(row0), "+v"(col0));
#pragma unroll
        for (int ai = 0; ai < 2; ++ai)
#pragma unroll
            for (int m = 0; m < 4; ++m)
#pragma unroll
                for (int bj = 0; bj < 2; ++bj) {
                    const size_t row = (size_t)(row0 + ai * HALF + m * 16);
                    const u32x2 gb = *(const u32x2*)((const unsigned char*)G + row * 4096 + 2048 + col0 + bj * HALF);
                    float s[8];
#pragma unroll
                    for (int i = 0; i < 2; ++i) { const f32x2 b01 = __builtin_amdgcn_cvt_pk_f32_fp8((int)gb[i], false), b23 = __builtin_amdgcn_cvt_pk_f32_fp8((int)gb[i], true);
                        s[4 * i] = __builtin_amdgcn_rcpf(1.f + sigmoid_neg_exp(b01[0])); s[4 * i + 1] = __builtin_amdgcn_rcpf(1.f + sigmoid_neg_exp(b01[1]));
                        s[4 * i + 2] = __builtin_amdgcn_rcpf(1.f + sigmoid_neg_exp(b23[0])); s[4 * i + 3] = __builtin_amdgcn_rcpf(1.f + sigmoid_neg_exp(b23[1])); }
                    const f32x4 v0 = acc[ai][bj][m][0], v1 = acc[ai][bj][m][1];
                    constexpr float SC = P4_FP8 ? 1.f / 32.f : 16.f;
                    u32x2 w; w.x = pk4_fp8(v0[0] * s[0] * SC, v0[1] * s[1] * SC, v0[2] * s[2] * SC, v0[3] * s[3] * SC);
                    w.y = pk4_fp8(v1[0] * s[4] * SC, v1[1] * s[5] * SC, v1[2] * s[6] * SC, v1[3] * s[7] * SC);
                    *(u32x2*)((unsigned char*)OUT + row * 2048 + col0 + bj * HALF) = w;
                    if (bj) asm volatile("" ::: "memory");
                }
    }
};
#ifndef DUP_EPI_OUT
#define DUP_EPI_OUT false
#endif
struct EpiOut {
    static constexpr bool PERM = true, HAS_MID = false, DUP_EPI = false;
    const float* X; float* OUT; bf16_t* X1B; float* ROWSS;
    __device__ __forceinline__ void mid(f32x4 (&)[2][2][4][2], const Unit&, int, int, int, int) const {}
    __device__ __forceinline__ void operator()(const f32x4 (&acc)[2][2][4][2], const Unit& u, int wr, int wc, int fr, int fq) const {
        const int row0 = u.pm * BM + wr * 64 + fr, col0 = u.pn * BM + wc * 32 + 8 * fq;
#pragma unroll
        for (int ai = 0; ai < 2; ++ai)
#pragma unroll
            for (int m = 0; m < 4; ++m) {
                const size_t row = (size_t)(row0 + ai * HALF + m * 16); float ss = 0.f;
#pragma unroll
                for (int bj = 0; bj < 2; ++bj) {
                    const size_t off = row * DM + col0 + bj * HALF;
                    const f32x4 v0 = *(const f32x4*)(X + off) + acc[ai][bj][m][0] * (1.f / 512.f);
                    const f32x4 v1 = *(const f32x4*)(X + off + 4) + acc[ai][bj][m][1] * (1.f / 512.f);
                    u32x4 w; w.x = cvt_pk_bf16(v0[0], v0[1]); w.y = cvt_pk_bf16(v0[2], v0[3]); w.z = cvt_pk_bf16(v1[0], v1[1]); w.w = cvt_pk_bf16(v1[2], v1[3]);
                    *(u32x4*)(X1B + off) = w;
                    ss += ((v0[0] * v0[0] + v0[1] * v0[1]) + (v0[2] * v0[2] + v0[3] * v0[3])) + ((v1[0] * v1[0] + v1[1] * v1[1]) + (v1[2] * v1[2] + v1[3] * v1[3]));
                }
                ss += __shfl_xor(ss, 16); ss += __shfl_xor(ss, 32);
                if (fq == 0) ROWSS[row * 32 + u.pn * 4 + wc] = ss;
            }
    }
};
struct EpiGU {
    static constexpr bool PERM = true, HAS_MID = false, DUP_EPI = false;
    const float* ROWSS; bf16_t* ACT;
    __device__ __forceinline__ void mid(f32x4 (&)[2][2][4][2], const Unit&, int, int, int, int) const {}
    __device__ __forceinline__ void operator()(const f32x4 (&acc)[2][2][4][2], const Unit& u, int wr, int wc, int fr, int fq) const {
        const int row0 = u.pm * BM + wr * 64 + fr, col0 = u.pn * HALF + wc * 32 + 8 * fq;
#pragma unroll
        for (int ai = 0; ai < 2; ++ai)
#pragma unroll
            for (int m = 0; m < 4; ++m) {
                const size_t row = (size_t)(row0 + ai * HALF + m * 16);
                const f32x4 p0 = *(const f32x4*)(ROWSS + row * 32 + fq * 8), p1 = *(const f32x4*)(ROWSS + row * 32 + fq * 8 + 4);
                float ss = ((p0[0] + p0[1]) + (p0[2] + p0[3])) + ((p1[0] + p1[1]) + (p1[2] + p1[3]));
                ss += __shfl_xor(ss, 16); ss += __shfl_xor(ss, 32);
                const float r = __builtin_amdgcn_rsqf(ss * (1.f / DM) + EPS);
                float o[8];
#pragma unroll
                for (int n = 0; n < 2; ++n)
#pragma unroll
                    for (int i = 0; i < 4; ++i) {
                        const float g = acc[ai][0][m][n][i] * r, up = acc[ai][1][m][n][i] * r;
                        o[n * 4 + i] = g * __builtin_amdgcn_rcpf(1.f + sigmoid_neg_exp(g)) * up;
                    }
                u32x4 w; w.x = cvt_pk_bf16(o[0], o[1]); w.y = cvt_pk_bf16(o[2], o[3]); w.z = cvt_pk_bf16(o[4], o[5]); w.w = cvt_pk_bf16(o[6], o[7]);
                *(u32x4*)(ACT + row * DFF + col0) = w;
            }
    }
};
struct EpiDown {
    static constexpr bool PERM = true, HAS_MID = false, DUP_EPI = false;
    const bf16_t* X1B; float* OUT;
    __device__ __forceinline__ void mid(f32x4 (&)[2][2][4][2], const Unit&, int, int, int, int) const {}
    __device__ __forceinline__ void operator()(const f32x4 (&acc)[2][2][4][2], const Unit& u, int wr, int wc, int fr, int fq) const {
        const int row0 = u.pm * BM + wr * 64 + fr, col0 = u.pn * BM + wc * 32 + 8 * fq;
#pragma unroll
        for (int ai = 0; ai < 2; ++ai)
#pragma unroll
            for (int m = 0; m < 4; ++m)
#pragma unroll
                for (int bj = 0; bj < 2; ++bj) {
                    const size_t off = (size_t)(row0 + ai * HALF + m * 16) * DM + col0 + bj * HALF;
                    const u32x4 xb = *(const u32x4*)(X1B + off); const f32x4 a0 = acc[ai][bj][m][0], a1 = acc[ai][bj][m][1];
                    *(f32x4*)(OUT + off) = (f32x4){bf_lo(xb.x) + a0[0], bf_hi(xb.x) + a0[1], bf_lo(xb.y) + a0[2], bf_hi(xb.y) + a0[3]};
                    *(f32x4*)(OUT + off + 4) = (f32x4){bf_lo(xb.z) + a1[0], bf_hi(xb.z) + a1[1], bf_lo(xb.w) + a1[2], bf_hi(xb.w) + a1[3]};
                }
    }
};
typedef int v8i32 __attribute__((ext_vector_type(8)));
typedef int v4i32 __attribute__((ext_vector_type(4)));
struct Frag2 { bf16x8 k[2]; };
template <bool F8> struct FragSel { typedef Frag2 T; };
template <> struct FragSel<true> { typedef v8i32 T; };
__device__ __forceinline__ void frag_ld(Frag2& d, const PG8_LAS unsigned char* p) { d.k[0] = *(const PG8_LAS bf16x8*)p; d.k[1] = *(const PG8_LAS bf16x8*)(p + 1024); }
__device__ __forceinline__ void frag_ld(v8i32& d, const PG8_LAS unsigned char* p) { const v4i32 lo = *(const PG8_LAS v4i32*)p, hi = *(const PG8_LAS v4i32*)(p + 1024); d = __builtin_shufflevector(lo, hi, 0, 1, 2, 3, 4, 5, 6, 7); }
__device__ __forceinline__ f32x4 frag_mma(const Frag2& b, const Frag2& a, f32x4 c) { c = __builtin_amdgcn_mfma_f32_16x16x32_bf16(b.k[0], a.k[0], c, 0, 0, 0); return __builtin_amdgcn_mfma_f32_16x16x32_bf16(b.k[1], a.k[1], c, 0, 0, 0); }
__device__ __forceinline__ f32x4 frag_mma(const v8i32& b, const v8i32& a, f32x4 c) {
    const int sc = 0x7f7f7f7f;
    asm volatile("v_mfma_scale_f32_16x16x128_f8f6f4 %0, %1, %2, %0, %3, %3 op_sel_hi:[0,0,0]" : "+v"(c) : "v"(b), "v"(a), "v"(sc));
    return c;
}
__device__ __forceinline__ void mma_drain() { asm volatile("s_nop 15\n\ts_nop 15" ::: "memory"); }
__device__ __forceinline__ f32x4 mma_fp8(bf16x8 b0, bf16x8 b1, bf16x8 a0, bf16x8 a1, f32x4 c) {
    const v4i32 B0 = __builtin_bit_cast(v4i32, b0), B1 = __builtin_bit_cast(v4i32, b1), A0 = __builtin_bit_cast(v4i32, a0), A1 = __builtin_bit_cast(v4i32, a1);
    return __builtin_amdgcn_mfma_scale_f32_16x16x128_f8f6f4(__builtin_shufflevector(B0, B1, 0, 1, 2, 3, 4, 5, 6, 7), __builtin_shufflevector(A0, A1, 0, 1, 2, 3, 4, 5, 6, 7), c, 0, 0, 0, 0x7f7f7f7f, 0, 0x7f7f7f7f);
}
template <class Epi, class Sched, bool ALIGN_EPI = false, bool FP8 = false>
__device__ __forceinline__ void gemm_phase(PG8_LAS unsigned char* lds, const Gemm g, const Sched& S, const Epi& E, int wave_id) {
    const int wid = wave_id, lane = fresh_lane(), tid = wid * 64 + lane, wr = wid >> 2, wc = wid & 3, fr = lane & 15, fq = lane >> 4;
    const int K = FP8 ? g.K / 2 : g.K, nt = K / BK;
    unsigned voffA[2], voffB[2];
#pragma unroll
    for (int i = 0; i < 2; ++i) { int R, C; stage_rc(tid * 16 + i * 8192, R, C); const int Rb = Epi::PERM ? ((R & ~31) + perm32(R & 31)) : R;
        voffA[i] = (unsigned)(R * K + C) * 2u; voffB[i] = (unsigned)(Rb * K + C) * 2u; }
    const size_t kstep = (size_t)(BK * 2);
    const size_t hstep = (size_t)HALF * K * 2;
    const size_t tstep = 2 * hstep;
    const unsigned ldsw = (unsigned)wid * 1024u;
    const int aoff = lds_byte(wr * 64 + fr, fq * 8), boff = lds_byte(wc * 32 + fr, fq * 8);
#define PG8_SA(b, h) (((b) * 2 + (h)) * HTB)
#define PG8_SB(b, h) ((4 + (b) * 2 + (h)) * HTB)
#define PG8_STAGE(bufoff, gbase, voff) do { _Pragma("unroll") for (int _i = 0; _i < 2; ++_i) \
        __builtin_amdgcn_global_load_lds((const unsigned*)((const char*)(gbase) + (voff)[_i]), (PG8_LAS unsigned*)(lds + (bufoff) + ldsw + _i * 8192), 16, 0, 0); } while (0)
#define PG8_LDA(dst, b, h) do { _Pragma("unroll") for (int m = 0; m < 4; ++m) frag_ld(dst[m], lds + PG8_SA(b, h) + aoff + m * 2048); } while (0)
#define PG8_LDB(dst, b, h) do { _Pragma("unroll") for (int n = 0; n < 2; ++n) frag_ld(dst[n], lds + PG8_SB(b, h) + boff + n * 2048); } while (0)
#define PG8_MMA(ai, bj, At, Bt) do { __builtin_amdgcn_s_setprio(1); _Pragma("unroll") for (int m = 0; m < 4; ++m) _Pragma("unroll") for (int n = 0; n < 2; ++n) \
        acc[ai][bj][m][n] = frag_mma(Bt[n], At[m], acc[ai][bj][m][n]); __builtin_amdgcn_s_setprio(0); } while (0)
#define PG8_WAIT_V(n) asm volatile("s_waitcnt vmcnt(" #n ")" ::: "memory")
#define PG8_WAIT_L(n) asm volatile("s_waitcnt lgkmcnt(" #n ")" ::: "memory")
#define PG8_BAR __builtin_amdgcn_s_barrier()
#define PG8_SCHED __builtin_amdgcn_sched_barrier(0)
    Unit cur, nxt; int ui = 0;
    if (!S.next(0, cur)) return;
    f32x4 acc[2][2][4][2];
#pragma unroll
    for (int a = 0; a < 2; ++a)
#pragma unroll
        for (int b = 0; b < 2; ++b)
#pragma unroll
            for (int m = 0; m < 4; ++m)
#pragma unroll
                for (int n = 0; n < 2; ++n) acc[a][b][m][n] = (f32x4){0.f, 0.f, 0.f, 0.f};
    typedef typename FragSel<FP8>::T FragT;
    FragT At[4], B0[2], B1[2];
    const char* cA = (const char*)g.A + (size_t)cur.pm * tstep; const char* cB = (const char*)g.Bt + (size_t)cur.pn * tstep;
    PG8_STAGE(PG8_SB(0, 0), cB, voffB); PG8_STAGE(PG8_SB(0, 1), cB + hstep, voffB); PG8_STAGE(PG8_SA(0, 0), cA, voffA); PG8_STAGE(PG8_SA(0, 1), cA + hstep, voffA);
    if (wr == 1) PG8_BAR;
    PG8_WAIT_V(2); PG8_BAR;
    PG8_STAGE(PG8_SB(1, 0), cB + kstep, voffB); PG8_STAGE(PG8_SA(1, 0), cA + kstep, voffA); PG8_STAGE(PG8_SB(1, 1), cB + hstep + kstep, voffB);
    PG8_WAIT_V(6); PG8_BAR;
    for (;;) {
        const bool has_next = S.next(ui + 1, nxt);
        const char* nA = has_next ? (const char*)g.A + (size_t)nxt.pm * tstep : cA; const char* nB = has_next ? (const char*)g.Bt + (size_t)nxt.pn * tstep : cB;
        for (int t = 0; t < nt; t += 2) {
            const bool last = (t == nt - 2);
            const char* a1 = cA + (size_t)(t + 1) * kstep;
            const char* a2 = last ? nA : cA + (size_t)(t + 2) * kstep; const char* b2 = last ? nB : cB + (size_t)(t + 2) * kstep;
            const char* a3 = a2 + kstep; const char* b3 = b2 + kstep;
            if constexpr (Epi::HAS_MID) { if (t == Epi::MID_T) { if constexpr (FP8) mma_drain(); E.mid(acc, cur, wr, wc, fr, fq); } }
            PG8_LDB(B0, 0, 0); PG8_LDB(B1, 0, 1); PG8_SCHED; PG8_LDA(At, 0, 0); PG8_STAGE(PG8_SA(1, 1), a1 + hstep, voffA);
            PG8_WAIT_V(8); PG8_WAIT_L(0); PG8_BAR; PG8_MMA(0, 0, At, B0); PG8_MMA(0, 1, At, B1); PG8_BAR; PG8_SCHED;
            PG8_LDA(At, 0, 1); PG8_STAGE(PG8_SB(0, 0), b2, voffB); PG8_STAGE(PG8_SB(0, 1), b2 + hstep, voffB); PG8_STAGE(PG8_SA(0, 0), a2, voffA);
            PG8_WAIT_V(8); PG8_WAIT_L(0); PG8_BAR; PG8_MMA(1, 0, At, B0); PG8_MMA(1, 1, At, B1); PG8_BAR; PG8_SCHED;
            PG8_LDB(B0, 1, 0); PG8_LDB(B1, 1, 1); PG8_SCHED; PG8_LDA(At, 1, 0); PG8_STAGE(PG8_SA(0, 1), a2 + hstep, voffA);
            PG8_WAIT_V(8); PG8_WAIT_L(0); PG8_BAR; PG8_MMA(0, 0, At, B0); PG8_MMA(0, 1, At, B1); PG8_BAR; PG8_SCHED;
            PG8_LDA(At, 1, 1); PG8_STAGE(PG8_SB(1, 0), b3, voffB); PG8_STAGE(PG8_SB(1, 1), b3 + hstep, voffB); PG8_STAGE(PG8_SA(1, 0), a3, voffA);
            PG8_WAIT_V(8); PG8_WAIT_L(0); PG8_BAR; PG8_MMA(1, 0, At, B0); PG8_MMA(1, 1, At, B1); PG8_BAR; PG8_SCHED;
        }
        if constexpr (ALIGN_EPI) { if (wr == 0) PG8_BAR; }
        if constexpr (FP8) mma_drain();
        E(acc, cur, wr, wc, fr, fq);
        if constexpr (Epi::DUP_EPI) { asm volatile("" ::: "memory"); E(acc, cur, wr, wc, fr, fq); }
        if (!has_next) break;
#pragma unroll
        for (int a = 0; a < 2; ++a)
#pragma unroll
            for (int b = 0; b < 2; ++b)
#pragma unroll
                for (int m = 0; m < 4; ++m)
#pragma unroll
                    for (int n = 0; n < 2; ++n) acc[a][b][m][n] = (f32x4){0.f, 0.f, 0.f, 0.f};
        cur = nxt; cA = nA; cB = nB; ++ui;
        if constexpr (ALIGN_EPI) { if (wr == 1) PG8_BAR; }
    }
    PG8_WAIT_V(0);
    if constexpr (!ALIGN_EPI) { if (wr == 0) PG8_BAR; }
    PG8_BAR;
#undef PG8_SA
#undef PG8_SB
#undef PG8_STAGE
#undef PG8_LDA
#undef PG8_LDB
#undef PG8_MMA
#undef PG8_WAIT_V
#undef PG8_WAIT_L
#undef PG8_BAR
#undef PG8_SCHED
}
}

#define LAS __attribute__((address_space(3)))
typedef unsigned short bf16;
typedef short bf16x8 __attribute__((ext_vector_type(8)));
typedef short s16x4 __attribute__((ext_vector_type(4)));
typedef float f32x4 __attribute__((ext_vector_type(4)));
typedef float f32x16 __attribute__((ext_vector_type(16)));
typedef unsigned u32x4 __attribute__((ext_vector_type(4)));
typedef unsigned u32x2 __attribute__((ext_vector_type(2)));
constexpr int NWAVES = 8;
constexpr int RING_BYTES = 131072, LDS_BYTES = 147456;

struct Args {
    const float* in[15]; float* out; unsigned char* ws; int ph_lo, ph_hi, coop, pad;
};
struct Frame {
    LAS unsigned char* lds;
    int tid, lane, wave, vcu, G;
};
using pg8::cvt_pk_bf16; using pg8::bf_lo; using pg8::bf_hi;

__device__ __forceinline__ float wave_sum(float v) {
#pragma unroll
    for (int o = 1; o < 64; o <<= 1) v += __shfl_xor(v, o);
    return v;
}
__device__ __forceinline__ float wave_max(float v) {
#pragma unroll
    for (int o = 1; o < 64; o <<= 1) v = fmaxf(v, __shfl_xor(v, o));
    return v;
}
__device__ __forceinline__ int t5_bucket(int d) {
    if (d < 16) return d;
    const int thr[15] = {19, 21, 24, 27, 31, 35, 40, 46, 52, 59, 67, 77, 87, 99, 113};
    int b = 16;
#pragma unroll
    for (int k = 0; k < 15; ++k) b += (d >= thr[k]) ? 1 : 0;
    return b;
}

template <bool FP8W = false>
__device__ __forceinline__ void p0_transpose_item(const float* W, int ldw, int k0, int n0, bf16* WT, int ldt, int drow0, int koff, const float* kscale, LAS float* scr, int lane) {
    const int kr = lane >> 4, n4 = (lane & 15) * 4;
    f32x4 v[16];
#pragma unroll
    for (int i = 0; i < 16; ++i) v[i] = __builtin_nontemporal_load((const f32x4*)(W + (size_t)(k0 + 4 * i + kr) * ldw + n0 + n4));
    if (kscale) {
#pragma unroll
        for (int i = 0; i < 16; ++i) v[i] = v[i] * kscale[k0 + 4 * i + kr];
    }
#pragma unroll
    for (int i = 0; i < 16; ++i) { LAS float* d = scr + (4 * i + kr) * 65 + n4; d[0] = v[i][0]; d[1] = v[i][1]; d[2] = v[i][2]; d[3] = v[i][3]; }
    asm volatile("s_waitcnt lgkmcnt(0)" ::: "memory");
    const int c = lane & 7;
#pragma unroll
    for (int j = 0; j < 8; ++j) { const int n = (lane >> 3) + 8 * j; const LAS float* s = scr + (8 * c) * 65 + n;
        if constexpr (FP8W) {
            u32x2 o; o.x = pg8::pk4_fp8(s[0 * 65] * 32.f, s[1 * 65] * 32.f, s[2 * 65] * 32.f, s[3 * 65] * 32.f); o.y = pg8::pk4_fp8(s[4 * 65] * 32.f, s[5 * 65] * 32.f, s[6 * 65] * 32.f, s[7 * 65] * 32.f);
            *(u32x2*)((unsigned char*)WT + (size_t)(drow0 + n) * ldt + koff + k0 + 8 * c) = o;
        } else {
        u32x4 o; o.x = cvt_pk_bf16(s[0 * 65], s[1 * 65]); o.y = cvt_pk_bf16(s[2 * 65], s[3 * 65]); o.z = cvt_pk_bf16(s[4 * 65], s[5 * 65]); o.w = cvt_pk_bf16(s[6 * 65], s[7 * 65]);
        *(u32x4*)(WT + (size_t)(drow0 + n) * ldt + koff + k0 + 8 * c) = o; } }
    asm volatile("s_waitcnt lgkmcnt(0)" ::: "memory");
}
__device__ __forceinline__ void p0_weights(const Frame& F, const Args& a, int set, int gw, int NGW) {
    unsigned char* ws = a.ws;
    LAS float* scr = (LAS float*)(F.lds + F.wave * 16640);
    const float* w_in = a.in[2]; const float* w_a = a.in[9]; const float* w_b = a.in[10]; const float* w_out = a.in[11]; const float* g2 = a.in[12]; const float* w_gu = a.in[13]; const float* w_dn = a.in[14];
    constexpr int I_IN = (DM / 64) * (INW / 64), I_AB = (AW / 64) * (DM / 64), I_OUT = (DM / 64) * (DM / 64), I_GU = (DM / 64) * (2 * DFF / 64), I_DN = (DFF / 64) * (DM / 64);
    if (set == 0) {
        for (int it = gw; it < I_IN; it += NGW) {
            const int r = it, nb = INW / 64, kb = r / nb, n0 = (r % nb) * 64, gt = n0 >> 8, nin = n0 & 255;
            if (gt == 11 || gt >= 17) p0_transpose_item<true>(w_in, INW, kb * 64, n0, (bf16*)(ws + WS_WIN8), DM, (gt == 11 ? 0 : gt - 16) * 256 + nin, 0, nullptr, scr, F.lane);
            else p0_transpose_item(w_in, INW, kb * 64, n0, (bf16*)(ws + WS_WIN), DM, (gt < 11 ? gt : gt - 1) * 256 + nin, 0, nullptr, scr, F.lane);
        }
    } else {
        for (int it = gw; it < 2 * I_AB + I_OUT + I_DN + I_GU; it += NGW) {
            int r = it;
            if (r >= 2 * I_AB + I_OUT + I_DN) { r -= 2 * I_AB + I_OUT + I_DN; const int nb = 2 * DFF / 64, kb = r / nb, n0 = (r % nb) * 64;
              const int j = n0 < DFF ? n0 : n0 - DFF, drow = (j / 128) * 256 + (n0 < DFF ? 0 : 128) + (j % 128);
              p0_transpose_item(w_gu, 2 * DFF, kb * 64, n0, (bf16*)(ws + WS_WGU), DM, drow, 0, g2, scr, F.lane); continue; }
            if (r < I_AB) { const int nb = DM / 64, kb = r / nb, n0 = (r % nb) * 64; p0_transpose_item<(P4_FP8 != 0)>(w_a, DM, kb * 64, n0, (bf16*)(ws + WS_WAB), DM, n0, 0, nullptr, scr, F.lane); continue; } r -= I_AB;
            if (r < I_AB) { const int nb = DM / 64, kb = r / nb, n0 = (r % nb) * 64; p0_transpose_item<(P4_FP8 != 0)>(w_b, DM, kb * 64, n0, (bf16*)(ws + WS_WAB), DM, n0, AW, nullptr, scr, F.lane); continue; } r -= I_AB;
            if (r < I_OUT) { const int nb = DM / 64, kb = r / nb, n0 = (r % nb) * 64; p0_transpose_item<true>(w_out, DM, kb * 64, n0, (bf16*)(ws + WS_WOUT), DM, n0, 0, nullptr, scr, F.lane); continue; } r -= I_OUT;
            { const int nb = DM / 64, kb = r / nb, n0 = (r % nb) * 64; p0_transpose_item(w_dn, DM, kb * 64, n0, (bf16*)(ws + WS_WDN), DFF, n0, 0, nullptr, scr, F.lane); }
        }
    }
}
__device__ __forceinline__ void p0_prologue(const Frame& F_, const Args& a, int part) {
    Frame F = F_; F.lane = fresh_lane(); F.tid = F.wave * 64 + F.lane;
    unsigned char* ws = a.ws;
    const int gw = F.vcu * NWAVES + F.wave, NGW = F.G * NWAVES;
    if (part & 1) p0_weights(F, a, 0, gw, NGW);
    if (part & 4) p0_weights(F, a, 1, gw, NGW);
    const float* x = a.in[0]; const float* g1 = a.in[1]; bf16* XN = (bf16*)(ws + WS_RA); unsigned char* XN8 = (unsigned char*)a.out;
    f32x4 gv[8];
#pragma unroll
    for (int j = 0; j < 8; ++j) gv[j] = *((const f32x4*)g1 + F.lane + 64 * j);
    f32x4 vn[8];
    if (!(part & 2)) return;
    if (gw < M) {
#pragma unroll
        for (int j = 0; j < 8; ++j) vn[j] = __builtin_nontemporal_load((const f32x4*)(x + (size_t)gw * DM) + F.lane + 64 * j);
    }
    for (int m = gw; m < M; m += NGW) {
        f32x4 v[8]; float s = 0.f;
#pragma unroll
        for (int j = 0; j < 8; ++j) v[j] = vn[j];
        if (m + NGW < M) {
#pragma unroll
            for (int j = 0; j < 8; ++j) vn[j] = __builtin_nontemporal_load((const f32x4*)(x + (size_t)(m + NGW) * DM) + F.lane + 64 * j);
        }
#pragma unroll
        for (int j = 0; j < 8; ++j) s += (v[j][0] * v[j][0] + v[j][1] * v[j][1]) + (v[j][2] * v[j][2] + v[j][3] * v[j][3]);
        const float rs = __builtin_amdgcn_rsqf(wave_sum(s) * (1.f / DM) + EPS);
        u32x2* o8 = (u32x2*)(XN + (size_t)m * DM) + F.lane; unsigned* o4 = (unsigned*)(XN8 + (size_t)m * DM) + F.lane;
#pragma unroll
        for (int j = 0; j < 8; ++j) { const float y0 = v[j][0] * rs * gv[j][0], y1 = v[j][1] * rs * gv[j][1], y2 = v[j][2] * rs * gv[j][2], y3 = v[j][3] * rs * gv[j][3];
            u32x2 w; w.x = cvt_pk_bf16(y0, y1); w.y = cvt_pk_bf16(y2, y3); o8[64 * j] = w; o4[64 * j] = pg8::pk4_fp8(y0, y1, y2, y3); }
    }
    if (F.vcu == 0 && F.wave == 0) {
        const float* qna = a.in[3]; const float* kna = a.in[4]; const float* qnb = a.in[5]; const float* knb = a.in[6]; const float* rb = a.in[7]; const float* sinks = a.in[8];
        float* tbl = (float*)(ws + WS_TBL); const int l = F.lane;
        { float* gnt = (float*)(ws + WS_GNT); gnt[l] = qna[l]; gnt[64 + l] = qna[64 + l]; gnt[128 + l] = kna[l]; gnt[192 + l] = kna[64 + l]; gnt[256 + l] = qnb[l]; gnt[320 + l] = qnb[l]; gnt[384 + l] = knb[l]; gnt[448 + l] = knb[l]; }
        const float mqa = wave_max(fmaxf(fabsf(qna[l]), fabsf(qna[l + 64]))), mka = wave_max(fmaxf(fabsf(kna[l]), fabsf(kna[l + 64])));
        const float mqb = wave_max(fabsf(qnb[l])), mkb = wave_max(fabsf(knb[l]));
        for (int hh = 0; hh < NBH; ++hh) {
            const float mb = wave_max(rb[(l & 31) * NBH + hh]);
            float bl = (hh < AH ? 11.313708499f * mqa * mka : 8.f * mqb * mkb) + mb;
            if (hh >= AH) bl = fmaxf(bl, sinks[hh - AH]);
            const float BL2 = bl * LOG2E;
            for (int d = l; d <= 128; d += 64) tbl[hh * TBLW + d] = rb[t5_bucket(d) * NBH + hh] * LOG2E - BL2;
            if (l == 0) { tbl[hh * TBLW + 129] = -__builtin_inff(); tbl[hh * TBLW + 130] = hh >= AH ? __builtin_amdgcn_exp2f(sinks[hh - AH] * LOG2E - BL2) : 0.f; tbl[hh * TBLW + 131] = 0.f; }
        }
    }
}

__device__ __forceinline__ void p2_norm(const Frame& F_, const Args& a) {
    Frame F = F_; F.lane = fresh_lane(); F.tid = F.wave * 64 + F.lane;
    unsigned char* ws = a.ws;
    const int lane = F.lane, wave = F.wave;
    for (int u = F.vcu; u < 256; u += F.G) {
        const int type = u & 3, pm = u >> 2;
        if (type <= 2) {
            bf16* T = (bf16*)(ws + (type == 0 ? WS_QA : type == 1 ? WS_KA : WS_QB));
            const float* gn = a.in[type == 0 ? 3 : type == 1 ? 4 : 5];
            const int hd = type == 2 ? 64 : 128; const float qs = type == 0 ? 0.08838834764831845f * LOG2E : type == 2 ? 0.125f * LOG2E : 1.f;
            float gq[16];
#pragma unroll
            for (int j = 0; j < 16; ++j) gq[j] = gn[(lane * 16 + j) & (hd - 1)] * qs;
            float cs[16];
#pragma unroll
            for (int j = 0; j < 16; ++j) cs[j] = 0.f;
            for (int i = 0; i < 32; ++i) {
                bf16* p = T + (size_t)(pm * 256 + wave * 32 + i) * 1024 + lane * 16;
                const u32x4 w0 = *(const u32x4*)p, w1 = *(const u32x4*)(p + 8);
                float v[16];
#pragma unroll
                for (int j = 0; j < 4; ++j) { v[2 * j] = bf_lo(w0[j]); v[2 * j + 1] = bf_hi(w0[j]); v[8 + 2 * j] = bf_lo(w1[j]); v[9 + 2 * j] = bf_hi(w1[j]); }
                float ss = 0.f;
#pragma unroll
                for (int j = 0; j < 16; ++j) ss += v[j] * v[j];
                ss += __shfl_xor(ss, 1); ss += __shfl_xor(ss, 2); if (hd == 128) ss += __shfl_xor(ss, 4);
                const float rs = __builtin_amdgcn_rsqf(ss * (1.f / hd) + EPS);
#pragma unroll
                for (int j = 0; j < 16; ++j) { v[j] = v[j] * rs * gq[j]; cs[j] += v[j]; }
                u32x4 o0, o1;
#pragma unroll
                for (int j = 0; j < 4; ++j) { o0[j] = cvt_pk_bf16(v[2 * j], v[2 * j + 1]); o1[j] = cvt_pk_bf16(v[8 + 2 * j], v[9 + 2 * j]); }
                *(u32x4*)p = o0; *(u32x4*)(p + 8) = o1;
            }
            if (type == 1) {
                LAS float* red = (LAS float*)F.lds;
#pragma unroll
                for (int j = 0; j < 16; ++j) red[wave * 1024 + lane * 16 + j] = cs[j];
                __syncthreads();
                float* km = (float*)(ws + WS_KMEAN); const int b = pm / NBLK, n = pm % NBLK;
                for (int c = F.tid; c < 1024; c += 512) { float s = 0.f;
#pragma unroll
                    for (int w = 0; w < 8; ++w) s += red[w * 1024 + c];
                    km[(size_t)((b * AH + (c >> 7)) * NBLK + n) * AD + (c & 127)] = s * (1.f / LBLK); }
                __syncthreads();
            }
        } else {
            bf16* T = (bf16*)(ws + WS_KB); const float* gn = a.in[6];
            float gq[8];
#pragma unroll
            for (int j = 0; j < 8; ++j) gq[j] = gn[((lane & 7) * 8 + j)];
            for (int i = 0; i < 8; ++i) {
                bf16* p = T + (size_t)(pm * 256 + wave * 32 + i * 4 + (lane >> 4)) * 128 + (lane & 15) * 8;
                const u32x4 w0 = *(const u32x4*)p; float v[8];
#pragma unroll
                for (int j = 0; j < 4; ++j) { v[2 * j] = bf_lo(w0[j]); v[2 * j + 1] = bf_hi(w0[j]); }
                float ss = 0.f;
#pragma unroll
                for (int j = 0; j < 8; ++j) ss += v[j] * v[j];
                ss += __shfl_xor(ss, 1); ss += __shfl_xor(ss, 2); ss += __shfl_xor(ss, 4);
                const float rs = __builtin_amdgcn_rsqf(ss * (1.f / 64) + EPS);
                u32x4 o0;
#pragma unroll
                for (int j = 0; j < 4; ++j) o0[j] = cvt_pk_bf16(v[2 * j] * rs * gq[2 * j], v[2 * j + 1] * rs * gq[2 * j + 1]);
                *(u32x4*)p = o0;
            }
        }
    }
}

namespace att {
__device__ __forceinline__ int crow(int r, int hi) { return (r & 3) + 8 * (r >> 2) + 4 * hi; }
#define KSWZ(row, colB) ((row) * 256 + ((colB) ^ (((row) & 7) << 4)))
#define KSWZ64(row, colB) ((row) * 128 + ((colB) ^ (((row) & 7) << 4)))
__device__ __forceinline__ int v_off(int key, int d, int DB) { return ((key >> 3) * DB + (d >> 5)) * 512 + (key & 7) * 64 + (d & 31) * 2; }
typedef short v4i16_t __attribute__((ext_vector_type(4)));
__device__ __forceinline__ s16x4 vtr(const LAS unsigned char* p) { return __builtin_bit_cast(s16x4, __builtin_amdgcn_ds_read_tr16_b64_v4i16((LAS v4i16_t*)p)); }
__device__ __forceinline__ float swap_add(float v) { auto rr = __builtin_amdgcn_permlane32_swap(__float_as_uint(v), __float_as_uint(v), false, false); return __uint_as_float(rr[0]) + __uint_as_float(rr[1]); }
#define PK4(P, B_, OUT) do { unsigned a0 = cvt_pk_bf16(P[B_ + 0], P[B_ + 1]), a1 = cvt_pk_bf16(P[B_ + 2], P[B_ + 3]);                     \
        unsigned b0 = cvt_pk_bf16(P[B_ + 4], P[B_ + 5]), b1 = cvt_pk_bf16(P[B_ + 6], P[B_ + 7]);                                          \
        auto r0 = __builtin_amdgcn_permlane32_swap(a0, b0, false, false); auto r1 = __builtin_amdgcn_permlane32_swap(a1, b1, false, false); \
        u32x4 w = {r0[0], r1[0], r0[1], r1[1]}; OUT = __builtin_bit_cast(bf16x8, w); } while (0)

constexpr int A_V = 0, A_K = 32768, A_WS = 65536, A_TBL = 65536 + 2048, A_STG = 0;
constexpr int B_WS = 98304, B_TBL = 98304 + 2048, B_STG = 106496;

__device__ __forceinline__ void moba_unit(int tid, int b, int h, int qb, const bf16* QA, const bf16* KA, const bf16* VA, bf16* Y, const float* kmean, const float* tblg, LAS unsigned char* lds) {
    const int wid = __builtin_amdgcn_readfirstlane(tid >> 6), lane = tid & 63, r32 = lane & 31, hi = lane >> 5;
    LAS float* wsf = (LAS float*)(lds + A_WS) + wid * 64; LAS float* tbl = (LAS float*)(lds + A_TBL);
    const size_t rowbase = (size_t)b * SEQ;
    if (tid < TBLW) tbl[tid] = tblg[h * TBLW + tid];
    const bf16* Qw = QA + (rowbase + qb * LBLK + wid * 32 + r32) * AW + h * AD;
    bf16x8 qr[8];
#pragma unroll
    for (int d0 = 0; d0 < 8; ++d0) qr[d0] = *(const bf16x8*)(Qw + d0 * 16 + hi * 8);
    const bf16* Ksrc; const bf16* Vsrc;
    { const int krow = 8 * wid + (lane >> 4), kch = (lane & 15) ^ (krow & 7);
      const int vs = 4 * wid + (lane >> 5), vkey = (vs >> 2) * 8 + ((lane & 31) >> 2), vd = (vs & 3) * 32 + (lane & 3) * 8;
      Ksrc = KA + (rowbase + krow) * AW + h * AD + kch * 8; Vsrc = VA + (rowbase + vkey) * AW + h * AD + vd; }
    const int k1off = 4 * AW + ((((lane & 15) ^ ((8 * wid + (lane >> 4) + 4) & 7)) - ((lane & 15) ^ ((8 * wid + (lane >> 4)) & 7))) * 8);
#define DMA_TILE(t, bf) do { const size_t o_ = (size_t)(t) * 64 * AW; \
        __builtin_amdgcn_global_load_lds((const unsigned*)(Ksrc + o_), (LAS unsigned*)(lds + A_K + (bf) * 16384 + wid * 2048), 16, 0, 0); \
        __builtin_amdgcn_global_load_lds((const unsigned*)(Ksrc + o_ + k1off), (LAS unsigned*)(lds + A_K + (bf) * 16384 + wid * 2048 + 1024), 16, 0, 0); \
        __builtin_amdgcn_global_load_lds((const unsigned*)(Vsrc + o_), (LAS unsigned*)(lds + A_V + (bf) * 16384 + wid * 2048), 16, 0, 0); \
        __builtin_amdgcn_global_load_lds((const unsigned*)(Vsrc + o_ + 64), (LAS unsigned*)(lds + A_V + (bf) * 16384 + wid * 2048 + 1024), 16, 0, 0); } while (0)
    unsigned selmask = 0u;
    if (qb > 0) {
        float v0 = -__builtin_inff(), v1 = v0, v2 = v0; int i0 = -1, i1 = -1, i2 = -1;
        const float* kmb = kmean + (size_t)((b * AH + h) * NBLK) * AD + hi * 8;
        for (int n = 0; n < qb; ++n) {
            const float* km = kmb + n * AD; float s = 0.f;
#pragma unroll
            for (int d0 = 0; d0 < 8; ++d0) { const f32x4 ka = *(const f32x4*)(km + d0 * 16), kb = *(const f32x4*)(km + d0 * 16 + 4);
                const u32x4 qw = __builtin_bit_cast(u32x4, qr[d0]);
                s += bf_lo(qw[0]) * ka[0] + bf_hi(qw[0]) * ka[1] + bf_lo(qw[1]) * ka[2] + bf_hi(qw[1]) * ka[3] + bf_lo(qw[2]) * kb[0] + bf_hi(qw[2]) * kb[1] + bf_lo(qw[3]) * kb[2] + bf_hi(qw[3]) * kb[3]; }
            s = swap_add(s);
            if (s > v0) { v2 = v1; i2 = i1; v1 = v0; i1 = i0; v0 = s; i0 = n; }
            else if (s > v1) { v2 = v1; i2 = i1; v1 = s; i1 = n; }
            else if (s > v2) { v2 = s; i2 = n; }
        }
        selmask = (i0 >= 0 ? 1u << i0 : 0u) | (i1 >= 0 ? 1u << i1 : 0u) | (i2 >= 0 ? 1u << i2 : 0u);
    }
    DMA_TILE(0, 0);
    __syncthreads();
    const int NT = 4 * (qb + 1);
    const int qw0 = qb * LBLK + wid * 32;
    const float c128 = tbl[128];
    float l_reg = 0.f; f32x16 o[4];
#pragma unroll
    for (int d = 0; d < 4; ++d) o[d] = f32x16{};
    const int vrb = hi * 4 * 512 + ((lane & 15) >> 2) * 64 + ((lane >> 4) & 1) * 32 + (lane & 3) * 8;
    for (int t = 0; t < NT; ++t) {
        const int cur = t & 1;
        if (t + 1 < NT) DMA_TILE(t + 1, cur ^ 1);
        const int k0 = t * 64, n = t >> 2;
        const bool active = (k0 <= qw0 + 31);
        if (active) {
            f32x16 p0 = f32x16{}, p1 = f32x16{};
            {   const LAS unsigned char* Kb = lds + A_K + cur * 16384;
                const LAS unsigned char* kb[4];
#pragma unroll
                for (int dd = 0; dd < 4; ++dd) kb[dd] = Kb + KSWZ(r32, (dd * 16 + hi * 8) * 2);
#pragma unroll
                for (int d0 = 0; d0 < 8; ++d0) { const LAS unsigned char* ap = kb[d0 & 3] + (d0 >> 2) * 128;
                    const bf16x8 b0 = *(const LAS bf16x8*)ap, b1 = *(const LAS bf16x8*)(ap + 32 * 256);
                    p0 = __builtin_amdgcn_mfma_f32_32x32x16_bf16(b0, qr[d0], p0, 0, 0, 0);
                    p1 = __builtin_amdgcn_mfma_f32_32x32x16_bf16(b1, qr[d0], p1, 0, 0, 0);
                    if (d0 == 3) __builtin_amdgcn_sched_barrier(0); } }
            const bool sel = (n == qb) || ((selmask >> n) & 1u);
            const bool nearb = (qw0 - (k0 + 63) < 128);
            if (nearb) {
                int dq = qw0 + r32 - k0 - 4 * hi;
                asm volatile("" : "+v"(dq));
#pragma unroll
                for (int r = 0; r < 16; ++r) { const int c = (r & 3) + 8 * (r >> 2);
                    const int d0_ = dq - c, d1_ = dq - c - 32;
                    const int x0 = (d0_ < 0 || !sel) ? 129 : (d0_ > 128 ? 128 : d0_), x1 = (d1_ < 0 || !sel) ? 129 : (d1_ > 128 ? 128 : d1_);
                    p0[r] = __builtin_amdgcn_exp2f(p0[r] + tbl[x0]); p1[r] = __builtin_amdgcn_exp2f(p1[r] + tbl[x1]);
                    if ((r & 3) == 3) __builtin_amdgcn_sched_barrier(0); }
            } else {
                const float ca = sel ? c128 : -__builtin_inff();
#pragma unroll
                for (int r = 0; r < 16; ++r) { p0[r] = __builtin_amdgcn_exp2f(p0[r] + ca); p1[r] = __builtin_amdgcn_exp2f(p1[r] + ca); }
            }
            float ps = 0.f;
#pragma unroll
            for (int r = 0; r < 16; ++r) ps += p0[r];
#pragma unroll
            for (int r = 0; r < 16; ++r) ps += p1[r];
            l_reg += ps;
            bf16x8 pa0, pa1, pa2, pa3;
            PK4(p0, 0, pa0); PK4(p0, 8, pa1); PK4(p1, 0, pa2); PK4(p1, 8, pa3);
            const LAS unsigned char* Vb = lds + A_V + cur * 16384 + vrb;
#pragma unroll
            for (int d0 = 0; d0 < 4; ++d0) {
#define VFRAG(ks) ({ const s16x4 lo_ = vtr(Vb + (2 * (ks) * 4 + d0) * 512), hi_ = vtr(Vb + (2 * (ks) * 4 + d0) * 512 + 256); (bf16x8){lo_[0], lo_[1], lo_[2], lo_[3], hi_[0], hi_[1], hi_[2], hi_[3]}; })
                o[d0] = __builtin_amdgcn_mfma_f32_32x32x16_bf16(pa0, VFRAG(0), o[d0], 0, 0, 0);
                o[d0] = __builtin_amdgcn_mfma_f32_32x32x16_bf16(pa1, VFRAG(1), o[d0], 0, 0, 0);
                o[d0] = __builtin_amdgcn_mfma_f32_32x32x16_bf16(pa2, VFRAG(2), o[d0], 0, 0, 0);
                o[d0] = __builtin_amdgcn_mfma_f32_32x32x16_bf16(pa3, VFRAG(3), o[d0], 0, 0, 0);
#undef VFRAG
            }
        }
        __syncthreads();
    }
    l_reg = swap_add(l_reg);
    int lane_e = lane; asm volatile("" : "+v"(lane_e));
    const int r32e = lane_e & 31, hie = lane_e >> 5;
    if (hie == 0) wsf[r32e] = l_reg;
    asm volatile("s_waitcnt lgkmcnt(0)" ::: "memory");
#if P4_FP8
    LAS unsigned char* stg = lds + A_STG + wid * 4096;
    { LAS unsigned char* sp = stg + (4 * hie) * 128 + r32e; const LAS float* wl = wsf + 4 * hie;
#pragma unroll
    for (int r = 0; r < 16; ++r) { const int oc = (r & 3) + 8 * (r >> 2); const float rl = __builtin_amdgcn_rcpf(wl[oc]) * 16.f;
#pragma unroll
        for (int d0 = 0; d0 < 4; ++d0) sp[oc * 128 + d0 * 32] = (unsigned char)__builtin_amdgcn_cvt_pk_fp8_f32(o[d0][r] * rl, 0.f, 0, false); } }
    asm volatile("s_waitcnt lgkmcnt(0)" ::: "memory");
    unsigned char* Yw = (unsigned char*)Y + (rowbase + qb * LBLK + wid * 32) * DM + h * AD;
#pragma unroll
    for (int i = 0; i < 4; ++i) { const int row = i * 8 + (lane_e >> 3), ch = lane_e & 7; *(u32x4*)(Yw + (size_t)row * DM + ch * 16) = *(const LAS u32x4*)(stg + row * 128 + ch * 16); }
#else
    LAS bf16* stg = (LAS bf16*)(lds + A_STG + wid * 8192);
    { LAS bf16* sp = stg + (4 * hie) * 128 + r32e; const LAS float* wl = wsf + 4 * hie;
#pragma unroll
    for (int r = 0; r < 16; ++r) { const int oc = (r & 3) + 8 * (r >> 2); const float rl = __builtin_amdgcn_rcpf(wl[oc]);
#pragma unroll
        for (int d0 = 0; d0 < 4; ++d0) sp[oc * 128 + d0 * 32] = (bf16)(cvt_pk_bf16(o[d0][r] * rl, 0.f) & 0xffffu); } }
    asm volatile("s_waitcnt lgkmcnt(0)" ::: "memory");
    bf16* Yw = Y + (rowbase + qb * LBLK + wid * 32) * DM + h * AD;
#pragma unroll
    for (int i = 0; i < 8; ++i) { const int row = i * 4 + (lane_e >> 4), ch = lane_e & 15; *(u32x4*)(Yw + (size_t)row * DM + ch * 8) = *(const LAS u32x4*)(stg + row * 128 + ch * 8); }
#endif
    __syncthreads();
#undef DMA_TILE
}

__device__ __forceinline__ void swa_dma(int tid, int b, int kvh, int tq, const bf16* KB_, const bf16* VB_, LAS unsigned char* lds, int buf) {
    const int wid = __builtin_amdgcn_readfirstlane(tid >> 6), lane = tid & 63, t0 = tq * 64;
    const size_t rowbase = (size_t)b * SEQ;
#pragma unroll
    for (int i = 0; i < 3; ++i) { const int p = wid * 3 + i, key0 = t0 - 128 + 8 * p;
        if (key0 >= 0) {
            const int kr = lane >> 3, kch = (lane & 7) ^ ((8 * p + kr) & 7);
            __builtin_amdgcn_global_load_lds((const unsigned*)(KB_ + (rowbase + key0 + kr) * BKW + kvh * BD + kch * 8), (LAS unsigned*)(lds + buf * 49152 + p * 1024), 16, 0, 0);
            const int vk = (lane & 31) >> 2, vd = (lane >> 5) * 32 + (lane & 3) * 8;
            __builtin_amdgcn_global_load_lds((const unsigned*)(VB_ + (rowbase + key0 + vk) * BKW + kvh * BD + vd), (LAS unsigned*)(lds + buf * 49152 + 24576 + p * 1024), 16, 0, 0);
        } }
}
__device__ __forceinline__ void swa_compute(int tid, int b, int kvh, int tq, const bf16* QB_, bf16* Y, const float* tblg, LAS unsigned char* lds, int buf) {
    const int wid = __builtin_amdgcn_readfirstlane(tid >> 6), lane = tid & 63, r32 = lane & 31, hi = lane >> 5;
    const int hq = kvh * 8 + wid, t0 = tq * 64, c_lo = tq >= 2 ? 0 : 4 - 2 * tq;
    const size_t rowbase = (size_t)b * SEQ;
    LAS float* wsf = (LAS float*)(lds + B_WS) + wid * 64; LAS float* tbl = (LAS float*)(lds + B_TBL) + wid * TBLW;
    const LAS unsigned char* Kl = lds + buf * 49152; const LAS unsigned char* Vl = Kl + 24576;
    for (int i = lane; i < TBLW; i += 64) tbl[i] = tblg[(AH + hq) * TBLW + i];
    bf16x8 qr[2][4];
#pragma unroll
    for (int j = 0; j < 2; ++j)
#pragma unroll
        for (int d0 = 0; d0 < 4; ++d0) qr[j][d0] = *(const bf16x8*)(QB_ + (rowbase + t0 + 32 * j + r32) * BW + hq * BD + d0 * 16 + hi * 8);
    asm volatile("s_waitcnt lgkmcnt(0)" ::: "memory");
    const int vrb = hi * 2 * 512 + ((lane & 15) >> 2) * 64 + ((lane >> 4) & 1) * 32 + (lane & 3) * 8;
    const float sinkw = tbl[130];
#pragma unroll
    for (int j = 0; j < 2; ++j) {
        float l_reg = 0.f; f32x16 o[2]; o[0] = f32x16{}; o[1] = f32x16{};
#pragma unroll
        for (int cc = 0; cc < 5; ++cc) {
            const int c = cc + j;
            if (c >= c_lo) {
                f32x16 p0 = f32x16{};
#pragma unroll
                for (int d0 = 0; d0 < 4; ++d0) { const bf16x8 kf = *(const LAS bf16x8*)(Kl + KSWZ64(c * 32 + r32, (d0 * 16 + hi * 8) * 2));
                    p0 = __builtin_amdgcn_mfma_f32_32x32x16_bf16(kf, qr[j][d0], p0, 0, 0, 0); }
                int dq = 128 + r32 - 32 * cc - 4 * hi; float ps = 0.f;
                asm volatile("" : "+v"(dq));
#pragma unroll
                for (int r = 0; r < 16; ++r) { const int d_ = dq - ((r & 3) + 8 * (r >> 2)); const int x = (d_ < 0 || d_ >= WIN) ? 129 : d_;
                    p0[r] = __builtin_amdgcn_exp2f(p0[r] + tbl[x]); ps += p0[r]; }
                l_reg += ps;
                bf16x8 pa0, pa1; PK4(p0, 0, pa0); PK4(p0, 8, pa1);
                const LAS unsigned char* Vb = Vl + vrb + c * 4 * 1024;
#pragma unroll
                for (int d0 = 0; d0 < 2; ++d0) {
#define VFRAG(ks) ({ const s16x4 lo_ = vtr(Vb + (2 * (ks) * 2 + d0) * 512), hi_ = vtr(Vb + (2 * (ks) * 2 + d0) * 512 + 256); (bf16x8){lo_[0], lo_[1], lo_[2], lo_[3], hi_[0], hi_[1], hi_[2], hi_[3]}; })
                    o[d0] = __builtin_amdgcn_mfma_f32_32x32x16_bf16(pa0, VFRAG(0), o[d0], 0, 0, 0);
                    o[d0] = __builtin_amdgcn_mfma_f32_32x32x16_bf16(pa1, VFRAG(1), o[d0], 0, 0, 0);
#undef VFRAG
                }
            }
        }
        l_reg = swap_add(l_reg) + sinkw;
        if (hi == 0) wsf[r32] = l_reg;
        asm volatile("s_waitcnt lgkmcnt(0)" ::: "memory");
#if P4_FP8
        LAS unsigned char* stg = lds + B_STG + wid * 2048;
        { LAS unsigned char* sp = stg + (4 * hi) * 64 + r32; const LAS float* wl = wsf + 4 * hi;
#pragma unroll
        for (int r = 0; r < 16; ++r) { const int oc = (r & 3) + 8 * (r >> 2); const float rl = __builtin_amdgcn_rcpf(wl[oc]) * 16.f;
#pragma unroll
            for (int d0 = 0; d0 < 2; ++d0) sp[oc * 64 + d0 * 32] = (unsigned char)__builtin_amdgcn_cvt_pk_fp8_f32(o[d0][r] * rl, 0.f, 0, false); } }
        asm volatile("s_waitcnt lgkmcnt(0)" ::: "memory");
        unsigned char* Yw = (unsigned char*)Y + (rowbase + t0 + 32 * j) * DM + AW + hq * BD;
#pragma unroll
        for (int i = 0; i < 2; ++i) { const int row = i * 16 + (lane >> 2), ch = lane & 3; *(u32x4*)(Yw + (size_t)row * DM + ch * 16) = *(const LAS u32x4*)(stg + row * 64 + ch * 16); }
#else
        LAS bf16* stg = (LAS bf16*)(lds + B_STG + wid * 4096);
        { LAS bf16* sp = stg + (4 * hi) * 64 + r32; const LAS float* wl = wsf + 4 * hi;
#pragma unroll
        for (int r = 0; r < 16; ++r) { const int oc = (r & 3) + 8 * (r >> 2); const float rl = __builtin_amdgcn_rcpf(wl[oc]);
#pragma unroll
            for (int d0 = 0; d0 < 2; ++d0) sp[oc * 64 + d0 * 32] = (bf16)(cvt_pk_bf16(o[d0][r] * rl, 0.f) & 0xffffu); } }
        asm volatile("s_waitcnt lgkmcnt(0)" ::: "memory");
        bf16* Yw = Y + (rowbase + t0 + 32 * j) * DM + AW + hq * BD;
#pragma unroll
        for (int i = 0; i < 4; ++i) { const int row = i * 8 + (lane >> 3), ch = lane & 7; *(u32x4*)(Yw + (size_t)row * DM + ch * 8) = *(const LAS u32x4*)(stg + row * 64 + ch * 8); }
#endif
        asm volatile("s_waitcnt lgkmcnt(0)" ::: "memory");
    }
}
}

__device__ __forceinline__ void p3_attention(const Frame& F, const Args& a) {
    unsigned char* ws = a.ws;
    const bf16* QA = (const bf16*)(ws + WS_QA); const bf16* KA = (const bf16*)(ws + WS_KA); const bf16* VA = (const bf16*)(ws + WS_VA);
    const bf16* QB_ = (const bf16*)(ws + WS_QB); const bf16* KB_ = (const bf16*)(ws + WS_KB); const bf16* VB_ = (const bf16*)(ws + WS_VB);
    bf16* Y = (bf16*)(ws + WS_RB); const float* kmean = (const float*)(ws + WS_KMEAN); const float* tblg = (const float*)(ws + WS_TBL);
    const int tid = F.wave * 64 + fresh_lane();
#ifndef NO_MOBA
    for (int p = F.vcu; p < 256; p += F.G) {
        const int bh = p >> 3, s = p & 7;
#pragma unroll 1
        for (int e = 0; e < 2; ++e) att::moba_unit(tid, bh >> 3, bh & 7, e ? s : 15 - s, QA, KA, VA, Y, kmean, tblg, F.lds);
    }
#endif
#ifndef NO_SWA
    { int u = F.vcu, bufi = 0;
      if (u < 512) att::swa_dma(tid, u >> 7, (u >> 6) & 1, u & 63, KB_, VB_, F.lds, 0);
      __syncthreads();
      for (; u < 512; u += F.G) {
          const int un = u + F.G;
          if (un < 512) att::swa_dma(tid, un >> 7, (un >> 6) & 1, un & 63, KB_, VB_, F.lds, bufi ^ 1);
          att::swa_compute(tid, u >> 7, (u >> 6) & 1, u & 63, QB_, Y, tblg, F.lds, bufi);
          __syncthreads(); bufi ^= 1;
      } }
#endif
}


#define XB_TMO      128
#define XB_XCNT(j)  (256  + 64 * (j))
#define XB_XSUB(j)  (1280 + 64 * (j))
#define XB_XGEN(j)  (2304 + 64 * (j))
#define XB_TOP      3328
#define XB_TOPGEN   3392
#define XCD_BAR_WORDS 3456
#define XB_SPIN_CAP (1u << 18)
__device__ __forceinline__ unsigned xb_ld(unsigned* p)              { return __hip_atomic_load(p, __ATOMIC_RELAXED, __HIP_MEMORY_SCOPE_AGENT); }
__device__ __forceinline__ unsigned xb_add(unsigned* p, unsigned v) { return __hip_atomic_fetch_add(p, v, __ATOMIC_RELAXED, __HIP_MEMORY_SCOPE_AGENT); }
__device__ __forceinline__ unsigned xb_xcc_id() { return (unsigned)__builtin_amdgcn_s_getreg((3 << 11) | 20) & 0xFu; }
#define XB_SPIN(cond, bar) do { unsigned _sp = 0; while (cond) { __builtin_amdgcn_s_sleep(1); \
    if ((++_sp & 255u) == 0u) { if (xb_ld(&(bar)[XB_TMO])) break; if (_sp > XB_SPIN_CAP) { atomicAdd(&(bar)[XB_TMO], 1u); break; } } } } while (0)
struct XcdBarrier { unsigned* bar; unsigned x; volatile LAS unsigned* st; };
__device__ __forceinline__ XcdBarrier xcd_barrier_post(unsigned* bar, volatile LAS unsigned* st) {
    XcdBarrier b; b.bar = bar; b.x = xb_xcc_id(); b.st = st;
    if (threadIdx.x == 0) (void)xb_add(&bar[XB_XCNT(b.x)], 1u);
    return b;
}
__device__ __forceinline__ void xcd_barrier_complete(unsigned* bar, unsigned x, unsigned& nloc, unsigned& nx) {
    const unsigned G = gridDim.x * gridDim.y * gridDim.z;
    unsigned sum, cnt, mine, sp = 0u;
    for (;;) {
        sum = 0u; cnt = 0u; mine = 0u;
#pragma unroll
        for (unsigned j = 0; j < 16; ++j) { const unsigned c = xb_ld(&bar[XB_XCNT(j)]); sum += c; cnt += (c > 0u) ? 1u : 0u; mine = (j == x) ? c : mine; }
        if (sum == G) break;
        __builtin_amdgcn_s_sleep(1);
        if ((++sp & 255u) == 0u) { if (xb_ld(&bar[XB_TMO])) break; if (sp > XB_SPIN_CAP) { atomicAdd(&bar[XB_TMO], 1u); break; } }
    }
    nloc = mine > 0u ? mine : 1u; nx = cnt > 0u ? cnt : 1u;
}
__device__ __forceinline__ void xcd_barrier(const XcdBarrier& b) {
    asm volatile("s_waitcnt vmcnt(0)" ::: "memory");
    __syncthreads();
    if (threadIdx.x == 0) {
        unsigned* bar = b.bar;
        __builtin_amdgcn_s_waitcnt(0);
        unsigned nloc = b.st[0], nx = b.st[1];
        if (nloc == 0u) { xcd_barrier_complete(bar, b.x, nloc, nx); b.st[0] = nloc; b.st[1] = nx; }
        const unsigned old = xb_add(&bar[XB_XSUB(b.x)], 1u);
        const unsigned gen = old / nloc;
        if (old + 1u == (gen + 1u) * nloc) {
            __builtin_amdgcn_fence(__ATOMIC_RELEASE, "agent");
            asm volatile("s_waitcnt vmcnt(0)" ::: "memory");
            const unsigned og = xb_add(&bar[XB_TOP], 1u);
            const unsigned tg = og / nx;
            if (og + 1u == (tg + 1u) * nx) xb_add(&bar[XB_TOPGEN], 1u);
            else XB_SPIN(xb_ld(&bar[XB_TOPGEN]) == tg, bar);
            __builtin_amdgcn_fence(__ATOMIC_ACQUIRE, "agent");
            xb_add(&bar[XB_XGEN(b.x)], 1u);
            asm volatile("s_waitcnt vmcnt(0)" ::: "memory");
        } else {
            XB_SPIN(xb_ld(&bar[XB_XGEN(b.x)]) == gen, bar);
            __builtin_amdgcn_fence(__ATOMIC_ACQUIRE, "agent");
            asm volatile("s_waitcnt vmcnt(0)" ::: "memory");
        }
    }
    __syncthreads();
}

__global__ void __launch_bounds__(NWAVES * 64, 2) fwd_kernel(Args args) {
    extern __shared__ __attribute__((aligned(16))) unsigned char lds_raw[];
    Frame F;
    F.lds = (LAS unsigned char*)lds_raw;
    F.tid = threadIdx.x; F.lane = F.tid & 63; F.wave = __builtin_amdgcn_readfirstlane((int)threadIdx.x >> 6);
    F.G = gridDim.x; { const int bx = blockIdx.x; F.vcu = (F.G % 8 == 0) ? (bx % 8) * (F.G / 8) + bx / 8 : bx; }
    unsigned char* ws = args.ws;
    const int lo = args.ph_lo, hi = args.ph_hi;
    int cg_id = (int)blockIdx.x;
    volatile LAS unsigned* misc = (volatile LAS unsigned*)(F.lds + LDS_BYTES - 256);
    XcdBarrier xbar; xbar.bar = (unsigned*)(ws + WS_BAR); xbar.x = 0; xbar.st = misc + 8;
    if (args.coop) { if (F.tid == 0) { misc[8] = 0u; misc[9] = 0u; } xbar = xcd_barrier_post((unsigned*)(ws + WS_BAR), misc + 8); }
    if (args.coop && F.tid == 0) {
        const unsigned xcc = (unsigned)__builtin_amdgcn_s_getreg((3 << 11) | 20) & 0xFu;
        misc[0] = xcc; misc[1] = __hip_atomic_fetch_add((unsigned*)(ws + WS_BAR) + 3584 + 32 * xcc, 1u, __ATOMIC_RELAXED, __HIP_MEMORY_SCOPE_AGENT);
    }
#ifndef PHMASK
#define PHMASK 0xff
#endif
#ifndef DUP_PHASE
#define DUP_PHASE -1
#endif
#define IN(k) (((PHMASK >> (k)) & 1) && lo <= (k) && (k) < hi)
#define SEAM(k) do { if (IN(k) && IN((k) + 1)) { if (args.coop) xcd_barrier(xbar); } } while (0)
    const bool defer_w = DEFER_W && F.G == 256;
    if (IN(0)) { p0_prologue(F, args, defer_w ? 3 : 7); } SEAM(0);
    if (args.coop) {
        if (F.wave == 0 && fresh_lane() == 0) {
            const unsigned xcc = misc[0], rank = misc[1]; bool ok = (F.G % 8 == 0) && xcc < 8u;
            for (unsigned j = 0; j < 16; ++j) { const unsigned c = __hip_atomic_load((unsigned*)(ws + WS_BAR) + 3584 + 32 * j, __ATOMIC_RELAXED, __HIP_MEMORY_SCOPE_AGENT); ok = ok && (c == (j < 8u ? (unsigned)F.G / 8u : 0u)); }
            misc[2] = ok ? rank * 8u + xcc : (unsigned)blockIdx.x;
            misc[3] = ok ? xcc * ((unsigned)F.G / 8u) + rank : (unsigned)F.vcu;
        }
        __syncthreads();
        cg_id = (int)misc[2]; F.vcu = (int)misc[3];
        cg_id = __builtin_amdgcn_readfirstlane(cg_id); F.vcu = __builtin_amdgcn_readfirstlane(F.vcu);
    }
    if (IN(1)) {
        { pg8::Gemm g{(const bf16*)(ws + WS_RA), (const bf16*)(ws + WS_WIN), M, 4096, DM}; pg8::StaticOrder S; S.init(M, 4096, F.G, cg_id);
          pg8::EpiProjNorm E{ws, F.lds + RING_BYTES};
          pg8::gemm_phase<pg8::EpiProjNorm, pg8::StaticOrder, true, false>(F.lds, g, S, E, F.wave); }
        { pg8::Gemm g{(const bf16*)args.out, (const bf16*)(ws + WS_WIN8), M, 4352, DM}; pg8::StaticOrder S; S.init(M, 4352, F.G, cg_id);
          pg8::EpiProj E{(bf16*)(ws + WS_QA), (bf16*)(ws + WS_KA), (bf16*)(ws + WS_VA), (bf16*)(ws + WS_QB), (bf16*)(ws + WS_KB), (bf16*)(ws + WS_VB), (bf16*)(ws + WS_G), 1, 1.f / 32.f};
          pg8::gemm_phase<pg8::EpiProj, pg8::StaticOrder, true, true>(F.lds, g, S, E, F.wave);
          if (defer_w) { pg8::Unit u5;
              if (!S.next(4, u5)) { Frame F2 = F; F2.lane = fresh_lane(); F2.tid = F2.wave * 64 + F2.lane;
                  const int nbusy = 17 * 64 - 4 * F.G, nidle = F.G - nbusy, rank = cg_id - nbusy;
                  p0_weights(F2, args, 1, rank * NWAVES + F.wave, nidle * NWAVES); } } }
    } SEAM(1);
    if (IN(3)) { for (int rep = 0; rep < (DUP_PHASE == 3 ? 2 : 1); ++rep) p3_attention(F, args); } SEAM(3);
    if (IN(4)) {
        pg8::Gemm g{(const bf16*)(ws + WS_RB), (const bf16*)(ws + WS_WAB), M, DM, DM}; pg8::StaticOrder S; S.init(M, DM, F.G, cg_id);
        pg8::EpiMerge E{(const bf16*)(ws + WS_G), (bf16*)(ws + WS_RA)};
        for (int rep = 0; rep < (DUP_PHASE == 4 ? 2 : 1); ++rep)
        pg8::gemm_phase<pg8::EpiMerge, pg8::StaticOrder, true, (P4_FP8 != 0)>(F.lds, g, S, E, F.wave);
    } SEAM(4);
    if (IN(5)) {
        pg8::Gemm g{(const bf16*)(ws + WS_RA), (const bf16*)(ws + WS_WOUT), M, DM, DM}; pg8::StaticOrder S; S.init(M, DM, F.G, cg_id);
        pg8::EpiOut E{args.in[0], args.out, (bf16*)(ws + WS_RB), (float*)(ws + WS_ROWSS)};
        for (int rep = 0; rep < (DUP_PHASE == 5 ? 2 : 1); ++rep)
        pg8::gemm_phase<pg8::EpiOut, pg8::StaticOrder, true, true>(F.lds, g, S, E, F.wave);
    } SEAM(5);
    if (IN(6)) {
        pg8::Gemm g{(const bf16*)(ws + WS_RB), (const bf16*)(ws + WS_WGU), M, 2 * DFF, DM}; pg8::StaticOrder S; S.init(M, 2 * DFF, F.G, cg_id);
        pg8::EpiGU E{(const float*)(ws + WS_ROWSS), (bf16*)(ws + WS_ACT)};
        for (int rep = 0; rep < (DUP_PHASE == 6 ? 2 : 1); ++rep)
        pg8::gemm_phase<pg8::EpiGU, pg8::StaticOrder, true>(F.lds, g, S, E, F.wave);
    } SEAM(6);
    if (IN(7)) {
        pg8::Gemm g{(const bf16*)(ws + WS_ACT), (const bf16*)(ws + WS_WDN), M, DM, DFF}; pg8::StaticOrder S; S.init(M, DM, F.G, cg_id);
        pg8::EpiDown E{(const bf16*)(ws + WS_RB), args.out};
        pg8::gemm_phase<pg8::EpiDown, pg8::StaticOrder, true>(F.lds, g, S, E, F.wave);
    }
#undef IN
#undef SEAM
}

extern "C" void kernel_launch(void* const* d_in, const int* in_sizes, int n_in, void* d_out, int out_size, void* d_ws, size_t ws_size, hipStream_t stream) {
    static int grid = 0;
    if (grid == 0) {
        if (n_in != 15 || in_sizes[0] != M * DM || out_size != M * DM || ws_size < WS_END) {
            fprintf(stderr, "kernel_launch: unexpected shapes (n_in %d, in0 %d, out %d, ws %zu need %zu); nothing launched\n", n_in, n_in > 0 ? in_sizes[0] : -1, out_size, ws_size, (size_t)WS_END); grid = -1; return; }
        int dev = 0, cus = 0, per_cu = 0;
        if (hipGetDevice(&dev) != hipSuccess || hipDeviceGetAttribute(&cus, hipDeviceAttributeMultiprocessorCount, dev) != hipSuccess) { grid = -1; return; }
        if (hipFuncSetAttribute((const void*)fwd_kernel, hipFuncAttributeMaxDynamicSharedMemorySize, LDS_BYTES) != hipSuccess) { fprintf(stderr, "kernel_launch: hipFuncSetAttribute failed\n"); grid = -1; return; }
        if (hipOccupancyMaxActiveBlocksPerMultiprocessor(&per_cu, (const void*)fwd_kernel, NWAVES * 64, LDS_BYTES) != hipSuccess || per_cu < 1) { fprintf(stderr, "kernel_launch: occupancy query says %d\n", per_cu); per_cu = 1; }
        (void)hipGetLastError();
        grid = cus * (per_cu < 1 ? 1 : per_cu);
        fprintf(stderr, "kernel_launch: cus %d per_cu %d grid %d\n", cus, per_cu, grid);
    }
    if (grid < 0) return;
    Args a{};
    for (int i = 0; i < 15; ++i) a.in[i] = (const float*)d_in[i];
    a.out = (float*)d_out; a.ws = (unsigned char*)d_ws;
    if (MK_N_LAUNCHES == 1) {
        a.ph_lo = 0; a.ph_hi = 8; a.coop = 1;
        if (hipMemsetAsync((char*)d_ws + WS_BAR, 0, 16384, stream) != hipSuccess) { fprintf(stderr, "kernel_launch: memset failed\n"); return; }
        void* kargs[] = {&a};
        hipError_t e = hipLaunchCooperativeKernel((const void*)fwd_kernel, dim3(grid), dim3(NWAVES * 64), kargs, LDS_BYTES, stream);
        if (e != hipSuccess) fprintf(stderr, "kernel_launch: cooperative launch failed: %s (grid %d)\n", hipGetErrorString(e), grid);
#ifdef PROBE_RERUN_REST
        a.ph_lo = 1; e = hipLaunchCooperativeKernel((const void*)fwd_kernel, dim3(grid), dim3(NWAVES * 64), kargs, LDS_BYTES, stream);
#endif
    } else {
        for (int p = 0; p < 8; ++p) {
            a.ph_lo = p; a.ph_hi = p + 1; a.coop = 0;
            hipLaunchKernelGGL(fwd_kernel, dim3(grid), dim3(NWAVES * 64), LDS_BYTES, stream, a);
        }
    }
}
```

```cpp
#include <hip/hip_runtime.h>
#include <hip/hip_cooperative_groups.h>
#include <cstdio>
#include <cstdint>
namespace cg = cooperative_groups;

#ifndef DEFER_W
#define DEFER_W 1
#endif
#ifndef P4_FP8
#define P4_FP8 1
#endif
#ifndef MK_N_LAUNCHES
#define MK_N_LAUNCHES 1
#endif

constexpr int DM = 2048, BATCH = 4, SEQ = 4096, M = BATCH * SEQ;
constexpr int AH = 8, AD = 128, AW = 1024, LBLK = 256, NBLK = SEQ / LBLK;
constexpr int BHQ = 16, BKVH = 2, BD = 64, BW = 1024, BKW = 128, WIN = 128;
constexpr int DFF = 5632, INW = 8448, NBH = 24;
constexpr float EPS = 1e-6f, LOG2E = 1.4426950408889634f;
constexpr int TBLW = 132;

constexpr size_t MiB = 1u << 20;
constexpr size_t WS_CTL = 0, WS_TBL = 4096, WS_GNT = 24576  , WS_BAR = 32768, WS_KMEAN = 65536;
constexpr size_t WS_ROWSS = 1 * MiB;
constexpr size_t WS_WIN = 3 * MiB  , WS_WIN8 = 20 * MiB  , WS_WAB = 36 * MiB, WS_WOUT = 44 * MiB, WS_WGU = 52 * MiB, WS_WDN = 96 * MiB;
constexpr size_t WS_RA = 118 * MiB;
constexpr size_t WS_RB = 182 * MiB;
constexpr size_t WS_QA = 246 * MiB, WS_KA = 278 * MiB, WS_VA = 310 * MiB, WS_QB = 342 * MiB, WS_KB = 374 * MiB, WS_VB = 378 * MiB;
constexpr size_t WS_G = 382 * MiB;
constexpr size_t WS_ACT = 246 * MiB;
constexpr size_t WS_END = 510 * MiB;
static_assert(WS_ACT + (size_t)M * DFF * 2 <= WS_END && WS_G + (size_t)M * 4096 * 2 <= WS_END, "ws map");

__device__ __forceinline__ int fresh_lane() { int l = (int)__builtin_amdgcn_mbcnt_hi(~0u, __builtin_amdgcn_mbcnt_lo(~0u, 0u)); asm volatile("" : "+v"(l)); return l; }
namespace pg8 {
#define PG8_LAS __attribute__((address_space(3)))
typedef unsigned short bf16_t;
typedef short bf16x8 __attribute__((ext_vector_type(8)));
typedef float f32x4 __attribute__((ext_vector_type(4)));
typedef float f32x2 __attribute__((ext_vector_type(2)));
typedef unsigned u32x4 __attribute__((ext_vector_type(4)));
typedef unsigned u32x2 __attribute__((ext_vector_type(2)));
constexpr int BM = 256, BK = 64, HALF = 128, HTB = HALF * BK * 2, STAGE_BYTES = 8 * HTB, NXCD = 8, WGM = 8;

__host__ __device__ __forceinline__ int lds_byte(int r, int c) { const int st = (r >> 4) * 2 + (c >> 5), rr = r & 15, cc = c & 31, ob = rr * 64 + cc * 2; return st * 1024 + (ob ^ (((ob >> 9) & 1) << 5)); }
__host__ __device__ __forceinline__ void stage_rc(int b, int& R, int& C) { const int st = b / 1024, sb = b % 1024, swz = sb ^ (((sb >> 9) & 1) << 5); R = (st >> 1) * 16 + swz / 64; C = (st & 1) * 32 + (swz % 64) / 2; }
__host__ __device__ __forceinline__ int perm32(int rho) { const int n = rho >> 4, i = rho & 15; return 8 * (i >> 2) + 4 * n + (i & 3); }

struct Unit { int pm, pn; };
struct Gemm { const bf16_t* A; const bf16_t* Bt; int M, N, K; };

struct StaticOrder {
    int nM, nN, nwg, G, c;
    __host__ __device__ void init(int M_, int N_, int G_, int c_) { nM = M_ / BM; nN = N_ / BM; nwg = nM * nN; G = G_; c = c_; }
    __host__ __device__ bool next(int i, Unit& u) const {
        const long L = (long)i * G + c; if (L >= nwg) return false;
        int wgid = (int)L; { const int q = nwg / NXCD, r = nwg % NXCD, xcd = wgid % NXCD, off = wgid / NXCD; wgid = (xcd < r ? xcd * (q + 1) : r * (q + 1) + (xcd - r) * q) + off; }
        const int nig = WGM * nN, gid = wgid / nig, fm = gid * WGM, gsz = (nM - fm) < WGM ? (nM - fm) : WGM;
        u.pm = fm + ((wgid % nig) % gsz); u.pn = (wgid % nig) / gsz; return true;
    }
};

__device__ __forceinline__ unsigned cvt_pk_bf16(float lo, float hi) {
    typedef __bf16 bf16x2_t __attribute__((ext_vector_type(2)));
    f32x2 v = {lo, hi}; bf16x2_t b = __builtin_convertvector(v, bf16x2_t); return __builtin_bit_cast(unsigned, b);
}
__device__ __forceinline__ unsigned pk4_fp8(float a, float b, float c, float d) { int p = __builtin_amdgcn_cvt_pk_fp8_f32(a, b, 0, false); return (unsigned)__builtin_amdgcn_cvt_pk_fp8_f32(c, d, p, true); }
__device__ __forceinline__ float bf_lo(unsigned w) { return __uint_as_float(w << 16); }
__device__ __forceinline__ float bf_hi(unsigned w) { return __uint_as_float(w & 0xffff0000u); }
__device__ __forceinline__ float sigmoid_neg_exp(float x) { return __builtin_amdgcn_exp2f(-x * LOG2E); }

struct EpiProj {
    static constexpr bool PERM = true, HAS_MID = false, DUP_EPI = false;
    bf16_t *QA, *KA, *VA, *QB, *KB, *VB, *G; int pn_off; float sc;
    __device__ __forceinline__ void mid(f32x4 (&)[2][2][4][2], const Unit&, int, int, int, int) const {}
    __device__ __forceinline__ void operator()(const f32x4 (&acc)[2][2][4][2], const Unit& u, int wr, int wc, int fr, int fq) const {
        const int row0 = u.pm * BM + wr * 64 + fr, cw = wc * 32 + 8 * fq, pn = pn_off == 0 ? (u.pn < 11 ? u.pn : u.pn + 1) : (u.pn == 0 ? 11 : u.pn + 16);
#pragma unroll
        for (int bj = 0; bj < 2; ++bj) {
            bf16_t* base; int ld, col;
            if (pn < 4) { base = QA; ld = 1024; col = pn * 256 + bj * 128 + cw; }
            else if (pn < 8) { base = KA; ld = 1024; col = (pn - 4) * 256 + bj * 128 + cw; }
            else if (pn < 12) { base = VA; ld = 1024; col = (pn - 8) * 256 + bj * 128 + cw; }
            else if (pn < 16) { base = QB; ld = 1024; col = (pn - 12) * 256 + bj * 128 + cw; }
            else if (pn == 16) { base = bj ? VB : KB; ld = 128; col = cw; }
            else { base = G; ld = 2048  ; col = (pn - 17) * 256 + bj * 128 + cw; }
#pragma unroll
            for (int ai = 0; ai < 2; ++ai)
#pragma unroll
                for (int m = 0; m < 4; ++m) {
                    const f32x4 v0 = acc[ai][bj][m][0] * sc, v1 = acc[ai][bj][m][1] * sc;
                    if (pn >= 17) {
                        u32x2 w; w.x = pk4_fp8(v0[0], v0[1], v0[2], v0[3]); w.y = pk4_fp8(v1[0], v1[1], v1[2], v1[3]);
                        *(u32x2*)((unsigned char*)base + (size_t)(row0 + ai * HALF + m * 16) * 4096 + col) = w;
                    } else {
                    u32x4 w; w.x = cvt_pk_bf16(v0[0], v0[1]); w.y = cvt_pk_bf16(v0[2], v0[3]); w.z = cvt_pk_bf16(v1[0], v1[1]); w.w = cvt_pk_bf16(v1[2], v1[3]);
                    *(u32x4*)(base + (size_t)(row0 + ai * HALF + m * 16) * ld + col) = w; }
                }
        }
    }
};

struct EpiProjNorm {
    static constexpr bool PERM = true, HAS_MID = false, DUP_EPI = false;
    unsigned char* ws; PG8_LAS unsigned char* xl;
    __device__ __forceinline__ void mid(f32x4 (&)[2][2][4][2], const Unit&, int, int, int, int) const {}
    __device__ __forceinline__ void operator()(f32x4 (&acc)[2][2][4][2], const Unit& u, int wr, int wc, int fr, int fq) const {
        const int gt = u.pn < 11 ? u.pn : u.pn + 1;
        int row0 = u.pm * BM + wr * 64 + fr, cw = wc * 32 + 8 * fq;
        asm volatile("" : "+v"(row0), "+v"(cw));
        if (gt >= 8 && gt <= 10) {
#pragma unroll
            for (int bj = 0; bj < 2; ++bj)
#pragma unroll
                for (int ai = 0; ai < 2; ++ai)
#pragma unroll
                    for (int m = 0; m < 4; ++m) { const f32x4 v0 = acc[ai][bj][m][0], v1 = acc[ai][bj][m][1];
                        u32x4 w; w.x = cvt_pk_bf16(v0[0], v0[1]); w.y = cvt_pk_bf16(v0[2], v0[3]); w.z = cvt_pk_bf16(v1[0], v1[1]); w.w = cvt_pk_bf16(v1[2], v1[3]);
                        *(u32x4*)((bf16_t*)(ws + WS_VA) + (size_t)(row0 + ai * HALF + m * 16) * 1024 + (gt - 8) * 256 + bj * HALF + cw) = w; }
            return;
        }
        PG8_LAS float* P = (PG8_LAS float*)xl;
        PG8_LAS float* KM = (PG8_LAS float*)(xl + 8192);
        const bool h64 = gt >= 12;
#pragma unroll
        for (int ai = 0; ai < 2; ++ai)
#pragma unroll
            for (int m = 0; m < 4; ++m)
#pragma unroll
                for (int bj = 0; bj < 2; ++bj) { const f32x4 a = acc[ai][bj][m][0], b = acc[ai][bj][m][1];
                    float ss = ((a[0] * a[0] + a[1] * a[1]) + (a[2] * a[2] + a[3] * a[3])) + ((b[0] * b[0] + b[1] * b[1]) + (b[2] * b[2] + b[3] * b[3]));
                    ss += __shfl_xor(ss, 16); ss += __shfl_xor(ss, 32);
                    if (fq == 0) P[((ai * HALF + wr * 64 + m * 16 + fr) * 2 + bj) * 4 + wc] = ss; }
        asm volatile("s_waitcnt lgkmcnt(0)" ::: "memory"); __builtin_amdgcn_s_barrier(); asm volatile("" ::: "memory");
        const float* gn = (const float*)(ws + WS_GNT) + (gt < 4 ? 0 : gt < 8 ? 128 : gt < 16 ? 256 : 384);
        const float qs = gt < 4 ? 0.08838834764831845f * LOG2E : (gt >= 12 && gt < 16) ? 0.125f * LOG2E : 1.f;
        const int dcol = h64 ? (cw & 63) : cw;
        const f32x4 g0 = *(const f32x4*)(gn + dcol) * qs, g1 = *(const f32x4*)(gn + dcol + 4) * qs;
        const float inv_hd = h64 ? (1.f / 64.f) : (1.f / 128.f);
        f32x4 cs[2][2];
#pragma unroll
        for (int bj = 0; bj < 2; ++bj) { cs[bj][0] = (f32x4){0.f, 0.f, 0.f, 0.f}; cs[bj][1] = (f32x4){0.f, 0.f, 0.f, 0.f}; }
#pragma unroll
        for (int bj = 0; bj < 2; ++bj) {
            size_t boff; int ld, col; bool nrm = true;
            if (gt < 4) { boff = WS_QA; ld = 1024; col = gt * 256 + bj * HALF + cw; }
            else if (gt < 8) { boff = WS_KA; ld = 1024; col = (gt - 4) * 256 + bj * HALF + cw; }
            else if (gt < 16) { boff = WS_QB; ld = 1024; col = (gt - 12) * 256 + bj * HALF + cw; }
            else { boff = bj ? WS_VB : WS_KB; ld = 128; col = cw; nrm = (bj == 0); }
            bf16_t* base = (bf16_t*)(ws + boff);
#pragma unroll
            for (int ai = 0; ai < 2; ++ai)
#pragma unroll
                for (int m = 0; m < 4; ++m) {
                    const int r = ai * HALF + wr * 64 + m * 16 + fr;
                    const f32x4 p = *(const PG8_LAS f32x4*)(P + (r * 2 + bj) * 4);
                    const float ss = h64 ? ((wc & 2) ? (p[2] + p[3]) : (p[0] + p[1])) : ((p[0] + p[1]) + (p[2] + p[3]));
                    const float rs = nrm ? __builtin_amdgcn_rsqf(ss * inv_hd + EPS) : 1.f;
                    f32x4 v0 = acc[ai][bj][m][0], v1 = acc[ai][bj][m][1];
                    if (nrm) { v0 = v0 * rs * g0; v1 = v1 * rs * g1; }
                    cs[bj][0] += v0; cs[bj][1] += v1; asm volatile("" : "+v"(cs[bj][0]), "+v"(cs[bj][1]));
                    u32x4 w; w.x = cvt_pk_bf16(v0[0], v0[1]); w.y = cvt_pk_bf16(v0[2], v0[3]); w.z = cvt_pk_bf16(v1[0], v1[1]); w.w = cvt_pk_bf16(v1[2], v1[3]);
                    *(u32x4*)(base + (size_t)(row0 + ai * HALF + m * 16) * ld + col) = w;
                    asm volatile("" ::: "memory");
                }
        }
        if (gt >= 4 && gt < 8) {
#pragma unroll
            for (int bj = 0; bj < 2; ++bj)
#pragma unroll
                for (int n = 0; n < 2; ++n)
#pragma unroll
                    for (int i = 0; i < 4; ++i) { float c = cs[bj][n][i]; c += __shfl_xor(c, 1); c += __shfl_xor(c, 2); c += __shfl_xor(c, 4); c += __shfl_xor(c, 8); cs[bj][n][i] = c; }
            if (fr == 0) {
#pragma unroll
                for (int bj = 0; bj < 2; ++bj) { *(PG8_LAS f32x4*)(KM + wr * 256 + bj * HALF + cw) = cs[bj][0]; *(PG8_LAS f32x4*)(KM + wr * 256 + bj * HALF + cw + 4) = cs[bj][1]; }
            }
            asm volatile("s_waitcnt lgkmcnt(0)" ::: "memory"); __builtin_amdgcn_s_barrier(); asm volatile("" ::: "memory");
            const int t = (wr * 4 + wc) * 64 + fq * 16 + fr;
            if (t < 256) { const int b = u.pm / NBLK, nb = u.pm % NBLK, hh = (gt - 4) * 2 + (t >> 7), d = t & 127;
                ((float*)(ws + WS_KMEAN))[(size_t)((b * AH + hh) * NBLK + nb) * AD + d] = (KM[t] + KM[256 + t]) * (1.f / LBLK); }
        }
    }
};
struct EpiMerge {
    static constexpr bool PERM = true, HAS_MID = true, DUP_EPI = false;
    static constexpr int MID_T = P4_FP8 ? 8 : 16;
    const bf16_t* G; bf16_t* OUT;
    __device__ __forceinline__ void mid(f32x4 (&acc)[2][2][4][2], const Unit& u, int wr, int wc, int fr, int fq) const {
        int row0 = u.pm * BM + wr * 64 + fr, col0 = u.pn * BM + wc * 32 + 8 * fq;
        asm volatile("" : "+v"(row0), "+v"(col0));
#pragma unroll
        for (int ai = 0; ai < 2; ++ai)
#pragma unroll
            for (int m = 0; m < 4; ++m)
#pragma unroll
                for (int bj = 0; bj < 2; ++bj) {
                    const unsigned char* gp = (const unsigned char*)G + (size_t)(row0 + ai * HALF + m * 16) * 4096 + col0 + bj * HALF;
                    const u32x2 ga = *(const u32x2*)gp, gb = *(const u32x2*)(gp + 2048);
                    float r[8];
#pragma unroll
                    for (int i = 0; i < 2; ++i) {
                        const f32x2 a01 = __builtin_amdgcn_cvt_pk_f32_fp8((int)ga[i], false), a23 = __builtin_amdgcn_cvt_pk_f32_fp8((int)ga[i], true);
                        const f32x2 b01 = __builtin_amdgcn_cvt_pk_f32_fp8((int)gb[i], false), b23 = __builtin_amdgcn_cvt_pk_f32_fp8((int)gb[i], true);
                        r[4 * i + 0] = (1.f + sigmoid_neg_exp(b01[0])) * __builtin_amdgcn_rcpf(1.f + sigmoid_neg_exp(a01[0]));
                        r[4 * i + 1] = (1.f + sigmoid_neg_exp(b01[1])) * __builtin_amdgcn_rcpf(1.f + sigmoid_neg_exp(a01[1]));
                        r[4 * i + 2] = (1.f + sigmoid_neg_exp(b23[0])) * __builtin_amdgcn_rcpf(1.f + sigmoid_neg_exp(a23[0]));
                        r[4 * i + 3] = (1.f + sigmoid_neg_exp(b23[1])) * __builtin_amdgcn_rcpf(1.f + sigmoid_neg_exp(a23[1]));
                    }
                    f32x4& a0 = acc[ai][bj][m][0]; f32x4& a1 = acc[ai][bj][m][1];
                    a0[0] *= r[0]; a0[1] *= r[1]; a0[2] *= r[2]; a0[3] *= r[3]; a1[0] *= r[4]; a1[1] *= r[5]; a1[2] *= r[6]; a1[3] *= r[7];
                    if (bj) asm volatile("" ::: "memory");
                }
    }
    __device__ __forceinline__ void operator()(const f32x4 (&acc)[2][2][4][2], const Unit& u, int wr, int wc, int fr, int fq) const {
        int row0 = u.pm * BM + wr * 64 + fr, col0 = u.pn * BM + wc * 32 + 8 * fq;
        asm volatile("" : "+v"(row0), "+v"(col0));
#pragma unroll
        for (int ai = 0; ai < 2; ++ai)
#pragma unroll
            for (int m = 0; m < 4; ++m)
#pragma unroll
                for (int bj = 0; bj < 2; ++bj) {
                    const size_t row = (size_t)(row0 + ai * HALF + m * 16);
                    const u32x2 gb = *(const u32x2*)((const unsigned char*)G + row * 4096 + 2048 + col0 + bj * HALF);
                    float s[8];
#pragma unroll
                    for (int i = 0; i < 2; ++i) { const f32x2 b01 = __builtin_amdgcn_cvt_pk_f32_fp8((int)gb[i], false), b23 = __builtin_amdgcn_cvt_pk_f32_fp8((int)gb[i], true);
                        s[4 * i] = __builtin_amdgcn_rcpf(1.f + sigmoid_neg_exp(b01[0])); s[4 * i + 1] = __builtin_amdgcn_rcpf(1.f + sigmoid_neg_exp(b01[1]));
                        s[4 * i + 2] = __builtin_amdgcn_rcpf(1.f + sigmoid_neg_exp(b23[0])); s[4 * i + 3] = __builtin_amdgcn_rcpf(1.f + sigmoid_neg_exp(b23[1])); }
                    const f32x4 v0 = acc[ai][bj][m][0], v1 = acc[ai][bj][m][1];
                    constexpr float SC = P4_FP8 ? 1.f / 32.f : 16.f;
                    u32x2 w; w.x = pk4_fp8(v0[0] * s[0] * SC, v0[1] * s[1] * SC, v0[2] * s[2] * SC, v0[3] * s[3] * SC);
                    w.y = pk4_fp8(v1[0] * s[4] * SC, v1[1] * s[5] * SC, v1[2] * s[6] * SC, v1[3] * s[7] * SC);
                    *(u32x2*)((unsigned char*)OUT + row * 2048 + col0 + bj * HALF) = w;
                    if (bj) asm volatile("" ::: "memory");
                }
    }
};
#ifndef DUP_EPI_OUT
#define DUP_EPI_OUT false
#endif
struct EpiOut {
    static constexpr bool PERM = true, HAS_MID = false, DUP_EPI = false;
    const float* X; float* OUT; bf16_t* X1B; float* ROWSS;
    __device__ __forceinline__ void mid(f32x4 (&)[2][2][4][2], const Unit&, int, int, int, int) const {}
    __device__ __forceinline__ void operator()(const f32x4 (&acc)[2][2][4][2], const Unit& u, int wr, int wc, int fr, int fq) const {
        const int row0 = u.pm * BM + wr * 64 + fr, col0 = u.pn * BM + wc * 32 + 8 * fq;
#pragma unroll
        for (int ai = 0; ai < 2; ++ai)
#pragma unroll
            for (int m = 0; m < 4; ++m) {
                const size_t row = (size_t)(row0 + ai * HALF + m * 16); float ss = 0.f;
#pragma unroll
                for (int bj = 0; bj < 2; ++bj) {
                    const size_t off = row * DM + col0 + bj * HALF;
                    const f32x4 v0 = *(const f32x4*)(X + off) + acc[ai][bj][m][0] * (1.f / 512.f);
                    const f32x4 v1 = *(const f32x4*)(X + off + 4) + acc[ai][bj][m][1] * (1.f / 512.f);
                    u32x4 w; w.x = cvt_pk_bf16(v0[0], v0[1]); w.y = cvt_pk_bf16(v0[2], v0[3]); w.z = cvt_pk_bf16(v1[0], v1[1]); w.w = cvt_pk_bf16(v1[2], v1[3]);
                    *(u32x4*)(X1B + off) = w;
                    ss += ((v0[0] * v0[0] + v0[1] * v0[1]) + (v0[2] * v0[2] + v0[3] * v0[3])) + ((v1[0] * v1[0] + v1[1] * v1[1]) + (v1[2] * v1[2] + v1[3] * v1[3]));
                }
                ss += __shfl_xor(ss, 16); ss += __shfl_xor(ss, 32);
                if (fq == 0) ROWSS[row * 32 + u.pn * 4 + wc] = ss;
            }
    }
};
struct EpiGU {
    static constexpr bool PERM = true, HAS_MID = false, DUP_EPI = false;
    const float* ROWSS; bf16_t* ACT;
    __device__ __forceinline__ void mid(f32x4 (&)[2][2][4][2], const Unit&, int, int, int, int) const {}
    __device__ __forceinline__ void operator()(const f32x4 (&acc)[2][2][4][2], const Unit& u, int wr, int wc, int fr, int fq) const {
        const int row0 = u.pm * BM + wr * 64 + fr, col0 = u.pn * HALF + wc * 32 + 8 * fq;
#pragma unroll
        for (int ai = 0; ai < 2; ++ai)
#pragma unroll
            for (int m = 0; m < 4; ++m) {
                const size_t row = (size_t)(row0 + ai * HALF + m * 16);
                const f32x4 p0 = *(const f32x4*)(ROWSS + row * 32 + fq * 8), p1 = *(const f32x4*)(ROWSS + row * 32 + fq * 8 + 4);
                float ss = ((p0[0] + p0[1]) + (p0[2] + p0[3])) + ((p1[0] + p1[1]) + (p1[2] + p1[3]));
                ss += __shfl_xor(ss, 16); ss += __shfl_xor(ss, 32);
                const float r = __builtin_amdgcn_rsqf(ss * (1.f / DM) + EPS);
                float o[8];
#pragma unroll
                for (int n = 0; n < 2; ++n)
#pragma unroll
                    for (int i = 0; i < 4; ++i) {
                        const float g = acc[ai][0][m][n][i] * r, up = acc[ai][1][m][n][i] * r;
                        o[n * 4 + i] = g * __builtin_amdgcn_rcpf(1.f + sigmoid_neg_exp(g)) * up;
                    }
                u32x4 w; w.x = cvt_pk_bf16(o[0], o[1]); w.y = cvt_pk_bf16(o[2], o[3]); w.z = cvt_pk_bf16(o[4], o[5]); w.w = cvt_pk_bf16(o[6], o[7]);
                *(u32x4*)(ACT + row * DFF + col0) = w;
            }
    }
};
struct EpiDown {
    static constexpr bool PERM = true, HAS_MID = false, DUP_EPI = false;
    const bf16_t* X1B; float* OUT;
    __device__ __forceinline__ void mid(f32x4 (&)[2][2][4][2], const Unit&, int, int, int, int) const {}
    __device__ __forceinline__ void operator()(const f32x4 (&acc)[2][2][4][2], const Unit& u, int wr, int wc, int fr, int fq) const {
        const int row0 = u.pm * BM + wr * 64 + fr, col0 = u.pn * BM + wc * 32 + 8 * fq;
#pragma unroll
        for (int ai = 0; ai < 2; ++ai)
#pragma unroll
            for (int m = 0; m < 4; ++m)
#pragma unroll
                for (int bj = 0; bj < 2; ++bj) {
                    const size_t off = (size_t)(row0 + ai * HALF + m * 16) * DM + col0 + bj * HALF;
                    const u32x4 xb = *(const u32x4*)(X1B + off); const f32x4 a0 = acc[ai][bj][m][0], a1 = acc[ai][bj][m][1];
                    *(f32x4*)(OUT + off) = (f32x4){bf_lo(xb.x) + a0[0], bf_hi(xb.x) + a0[1], bf_lo(xb.y) + a0[2], bf_hi(xb.y) + a0[3]};
                    *(f32x4*)(OUT + off + 4) = (f32x4){bf_lo(xb.z) + a1[0], bf_hi(xb.z) + a1[1], bf_lo(xb.w) + a1[2], bf_hi(xb.w) + a1[3]};
                }
    }
};
typedef int v8i32 __attribute__((ext_vector_type(8)));
typedef int v4i32 __attribute__((ext_vector_type(4)));
struct Frag2 { bf16x8 k[2]; };
template <bool F8> struct FragSel { typedef Frag2 T; };
template <> struct FragSel<true> { typedef v8i32 T; };
__device__ __forceinline__ void frag_ld(Frag2& d, const PG8_LAS unsigned char* p) { d.k[0] = *(const PG8_LAS bf16x8*)p; d.k[1] = *(const PG8_LAS bf16x8*)(p + 1024); }
__device__ __forceinline__ void frag_ld(v8i32& d, const PG8_LAS unsigned char* p) { const v4i32 lo = *(const PG8_LAS v4i32*)p, hi = *(const PG8_LAS v4i32*)(p + 1024); d = __builtin_shufflevector(lo, hi, 0, 1, 2, 3, 4, 5, 6, 7); }
__device__ __forceinline__ f32x4 frag_mma(const Frag2& b, const Frag2& a, f32x4 c) { c = __builtin_amdgcn_mfma_f32_16x16x32_bf16(b.k[0], a.k[0], c, 0, 0, 0); return __builtin_amdgcn_mfma_f32_16x16x32_bf16(b.k[1], a.k[1], c, 0, 0, 0); }
__device__ __forceinline__ f32x4 frag_mma(const v8i32& b, const v8i32& a, f32x4 c) {
    const int sc = 0x7f7f7f7f;
    asm volatile("v_mfma_scale_f32_16x16x128_f8f6f4 %0, %1, %2, %0, %3, %3 op_sel_hi:[0,0,0]" : "+v"(c) : "v"(b), "v"(a), "v"(sc));
    return c;
}
__device__ __forceinline__ void mma_drain() { asm volatile("s_nop 15\n\ts_nop 15" ::: "memory"); }
__device__ __forceinline__ f32x4 mma_fp8(bf16x8 b0, bf16x8 b1, bf16x8 a0, bf16x8 a1, f32x4 c) {
    const v4i32 B0 = __builtin_bit_cast(v4i32, b0), B1 = __builtin_bit_cast(v4i32, b1), A0 = __builtin_bit_cast(v4i32, a0), A1 = __builtin_bit_cast(v4i32, a1);
    return __builtin_amdgcn_mfma_scale_f32_16x16x128_f8f6f4(__builtin_shufflevector(B0, B1, 0, 1, 2, 3, 4, 5, 6, 7), __builtin_shufflevector(A0, A1, 0, 1, 2, 3, 4, 5, 6, 7), c, 0, 0, 0, 0x7f7f7f7f, 0, 0x7f7f7f7f);
}
template <class Epi, class Sched, bool ALIGN_EPI = false, bool FP8 = false>
__device__ __forceinline__ void gemm_phase(PG8_LAS unsigned char* lds, const Gemm g, const Sched& S, const Epi& E, int wave_id) {
    const int wid = wave_id, lane = fresh_lane(), tid = wid * 64 + lane, wr = wid >> 2, wc = wid & 3, fr = lane & 15, fq = lane >> 4;
    const int K = FP8 ? g.K / 2 : g.K, nt = K / BK;
    unsigned voffA[2], voffB[2];
#pragma unroll
    for (int i = 0; i < 2; ++i) { int R, C; stage_rc(tid * 16 + i * 8192, R, C); const int Rb = Epi::PERM ? ((R & ~31) + perm32(R & 31)) : R;
        voffA[i] = (unsigned)(R * K + C) * 2u; voffB[i] = (unsigned)(Rb * K + C) * 2u; }
    const size_t kstep = (size_t)(BK * 2);
    const size_t hstep = (size_t)HALF * K * 2;
    const size_t tstep = 2 * hstep;
    const unsigned ldsw = (unsigned)wid * 1024u;
    const int aoff = lds_byte(wr * 64 + fr, fq * 8), boff = lds_byte(wc * 32 + fr, fq * 8);
#define PG8_SA(b, h) (((b) * 2 + (h)) * HTB)
#define PG8_SB(b, h) ((4 + (b) * 2 + (h)) * HTB)
#define PG8_STAGE(bufoff, gbase, voff) do { _Pragma("unroll") for (int _i = 0; _i < 2; ++_i) \
        __builtin_amdgcn_global_load_lds((const unsigned*)((const char*)(gbase) + (voff)[_i]), (PG8_LAS unsigned*)(lds + (bufoff) + ldsw + _i * 8192), 16, 0, 0); } while (0)
#define PG8_LDA(dst, b, h) do { _Pragma("unroll") for (int m = 0; m < 4; ++m) frag_ld(dst[m], lds + PG8_SA(b, h) + aoff + m * 2048); } while (0)
#define PG8_LDB(dst, b, h) do { _Pragma("unroll") for (int n = 0; n < 2; ++n) frag_ld(dst[n], lds + PG8_SB(b, h) + boff + n * 2048); } while (0)
#define PG8_MMA(ai, bj, At, Bt) do { __builtin_amdgcn_s_setprio(1); _Pragma("unroll") for (int m = 0; m < 4; ++m) _Pragma("unroll") for (int n = 0; n < 2; ++n) \
        acc[ai][bj][m][n] = frag_mma(Bt[n], At[m], acc[ai][bj][m][n]); __builtin_amdgcn_s_setprio(0); } while (0)
#define PG8_WAIT_V(n) asm volatile("s_waitcnt vmcnt(" #n ")" ::: "memory")
#define PG8_WAIT_L(n) asm volatile("s_waitcnt lgkmcnt(" #n ")" ::: "memory")
#define PG8_BAR __builtin_amdgcn_s_barrier()
#define PG8_SCHED __builtin_amdgcn_sched_barrier(0)
    Unit cur, nxt; int ui = 0;
    if (!S.next(0, cur)) return;
    f32x4 acc[2][2][4][2];
#pragma unroll
    for (int a = 0; a < 2; ++a)
#pragma unroll
        for (int b = 0; b < 2; ++b)
#pragma unroll
            for (int m = 0; m < 4; ++m)
#pragma unroll
                for (int n = 0; n < 2; ++n) acc[a][b][m][n] = (f32x4){0.f, 0.f, 0.f, 0.f};
    typedef typename FragSel<FP8>::T FragT;
    FragT At[4], B0[2], B1[2];
    const char* cA = (const char*)g.A + (size_t)cur.pm * tstep; const char* cB = (const char*)g.Bt + (size_t)cur.pn * tstep;
    PG8_STAGE(PG8_SB(0, 0), cB, voffB); PG8_STAGE(PG8_SB(0, 1), cB + hstep, voffB); PG8_STAGE(PG8_SA(0, 0), cA, voffA); PG8_STAGE(PG8_SA(0, 1), cA + hstep, voffA);
    if (wr == 1) PG8_BAR;
    PG8_WAIT_V(2); PG8_BAR;
    PG8_STAGE(PG8_SB(1, 0), cB + kstep, voffB); PG8_STAGE(PG8_SA(1, 0), cA + kstep, voffA); PG8_STAGE(PG8_SB(1, 1), cB + hstep + kstep, voffB);
    PG8_WAIT_V(6); PG8_BAR;
    for (;;) {
        const bool has_next = S.next(ui + 1, nxt);
        const char* nA = has_next ? (const char*)g.A + (size_t)nxt.pm * tstep : cA; const char* nB = has_next ? (const char*)g.Bt + (size_t)nxt.pn * tstep : cB;
        for (int t = 0; t < nt; t += 2) {
            const bool last = (t == nt - 2);
            const char* a1 = cA + (size_t)(t + 1) * kstep;
            const char* a2 = last ? nA : cA + (size_t)(t + 2) * kstep; const char* b2 = last ? nB : cB + (size_t)(t + 2) * kstep;
            const char* a3 = a2 + kstep; const char* b3 = b2 + kstep;
            if constexpr (Epi::HAS_MID) { if (t == Epi::MID_T) { if constexpr (FP8) mma_drain(); E.mid(acc, cur, wr, wc, fr, fq); } }
            PG8_LDB(B0, 0, 0); PG8_LDB(B1, 0, 1); PG8_SCHED; PG8_LDA(At, 0, 0); PG8_STAGE(PG8_SA(1, 1), a1 + hstep, voffA);
            PG8_WAIT_V(8); PG8_WAIT_L(0); PG8_BAR; PG8_MMA(0, 0, At, B0); PG8_MMA(0, 1, At, B1); PG8_BAR; PG8_SCHED;
            PG8_LDA(At, 0, 1); PG8_STAGE(PG8_SB(0, 0), b2, voffB); PG8_STAGE(PG8_SB(0, 1), b2 + hstep, voffB); PG8_STAGE(PG8_SA(0, 0), a2, voffA);
            PG8_WAIT_V(8); PG8_WAIT_L(0); PG8_BAR; PG8_MMA(1, 0, At, B0); PG8_MMA(1, 1, At, B1); PG8_BAR; PG8_SCHED;
            PG8_LDB(B0, 1, 0); PG8_LDB(B1, 1, 1); PG8_SCHED; PG8_LDA(At, 1, 0); PG8_STAGE(PG8_SA(0, 1), a2 + hstep, voffA);
            PG8_WAIT_V(8); PG8_WAIT_L(0); PG8_BAR; PG8_MMA(0, 0, At, B0); PG8_MMA(0, 1, At, B1); PG8_BAR; PG8_SCHED;
            PG8_LDA(At, 1, 1); PG8_STAGE(PG8_SB(1, 0), b3, voffB); PG8_STAGE(PG8_SB(1, 1), b3 + hstep, voffB); PG8_STAGE(PG8_SA(1, 0), a3, voffA);
            PG8_WAIT_V(8); PG8_WAIT_L(0); PG8_BAR; PG8_MMA(1, 0, At, B0); PG8_MMA(1, 1, At, B1); PG8_BAR; PG8_SCHED;
        }
        if constexpr (ALIGN_EPI) { if (wr == 0) PG8_BAR; }
        if constexpr (FP8) mma_drain();
        E(acc, cur, wr, wc, fr, fq);
        if constexpr (Epi::DUP_EPI) { asm volatile("" ::: "memory"); E(acc, cur, wr, wc, fr, fq); }
        if (!has_next) break;
#pragma unroll
        for (int a = 0; a < 2; ++a)
#pragma unroll
            for (int b = 0; b < 2; ++b)
#pragma unroll
                for (int m = 0; m < 4; ++m)
#pragma unroll
                    for (int n = 0; n < 2; ++n) acc[a][b][m][n] = (f32x4){0.f, 0.f, 0.f, 0.f};
        cur = nxt; cA = nA; cB = nB; ++ui;
        if constexpr (ALIGN_EPI) { if (wr == 1) PG8_BAR; }
    }
    PG8_WAIT_V(0);
    if constexpr (!ALIGN_EPI) { if (wr == 0) PG8_BAR; }
    PG8_BAR;
#undef PG8_SA
#undef PG8_SB
#undef PG8_STAGE
#undef PG8_LDA
#undef PG8_LDB
#undef PG8_MMA
#undef PG8_WAIT_V
#undef PG8_WAIT_L
#undef PG8_BAR
#undef PG8_SCHED
}
}

#define LAS __attribute__((address_space(3)))
typedef unsigned short bf16;
typedef short bf16x8 __attribute__((ext_vector_type(8)));
typedef short s16x4 __attribute__((ext_vector_type(4)));
typedef float f32x4 __attribute__((ext_vector_type(4)));
typedef float f32x16 __attribute__((ext_vector_type(16)));
typedef unsigned u32x4 __attribute__((ext_vector_type(4)));
typedef unsigned u32x2 __attribute__((ext_vector_type(2)));
constexpr int NWAVES = 8;
constexpr int RING_BYTES = 131072, LDS_BYTES = 147456;

struct Args {
    const float* in[15]; float* out; unsigned char* ws; int ph_lo, ph_hi, coop, pad;
};
struct Frame {
    LAS unsigned char* lds;
    int tid, lane, wave, vcu, G;
};
using pg8::cvt_pk_bf16; using pg8::bf_lo; using pg8::bf_hi;

__device__ __forceinline__ float wave_sum(float v) {
#pragma unroll
    for (int o = 1; o < 64; o <<= 1) v += __shfl_xor(v, o);
    return v;
}
__device__ __forceinline__ float wave_max(float v) {
#pragma unroll
    for (int o = 1; o < 64; o <<= 1) v = fmaxf(v, __shfl_xor(v, o));
    return v;
}
__device__ __forceinline__ int t5_bucket(int d) {
    if (d < 16) return d;
    const int thr[15] = {19, 21, 24, 27, 31, 35, 40, 46, 52, 59, 67, 77, 87, 99, 113};
    int b = 16;
#pragma unroll
    for (int k = 0; k < 15; ++k) b += (d >= thr[k]) ? 1 : 0;
    return b;
}

template <bool FP8W = false>
__device__ __forceinline__ void p0_transpose_item(const float* W, int ldw, int k0, int n0, bf16* WT, int ldt, int drow0, int koff, const float* kscale, LAS float* scr, int lane) {
    const int kr = lane >> 4, n4 = (lane & 15) * 4;
    f32x4 v[16];
#pragma unroll
    for (int i = 0; i < 16; ++i) v[i] = __builtin_nontemporal_load((const f32x4*)(W + (size_t)(k0 + 4 * i + kr) * ldw + n0 + n4));
    if (kscale) {
#pragma unroll
        for (int i = 0; i < 16; ++i) v[i] = v[i] * kscale[k0 + 4 * i + kr];
    }
#pragma unroll
    for (int i = 0; i < 16; ++i) { LAS float* d = scr + (4 * i + kr) * 65 + n4; d[0] = v[i][0]; d[1] = v[i][1]; d[2] = v[i][2]; d[3] = v[i][3]; }
    asm volatile("s_waitcnt lgkmcnt(0)" ::: "memory");
    const int c = lane & 7;
#pragma unroll
    for (int j = 0; j < 8; ++j) { const int n = (lane >> 3) + 8 * j; const LAS float* s = scr + (8 * c) * 65 + n;
        if constexpr (FP8W) {
            u32x2 o; o.x = pg8::pk4_fp8(s[0 * 65] * 32.f, s[1 * 65] * 32.f, s[2 * 65] * 32.f, s[3 * 65] * 32.f); o.y = pg8::pk4_fp8(s[4 * 65] * 32.f, s[5 * 65] * 32.f, s[6 * 65] * 32.f, s[7 * 65] * 32.f);
            *(u32x2*)((unsigned char*)WT + (size_t)(drow0 + n) * ldt + koff + k0 + 8 * c) = o;
        } else {
        u32x4 o; o.x = cvt_pk_bf16(s[0 * 65], s[1 * 65]); o.y = cvt_pk_bf16(s[2 * 65], s[3 * 65]); o.z = cvt_pk_bf16(s[4 * 65], s[5 * 65]); o.w = cvt_pk_bf16(s[6 * 65], s[7 * 65]);
        *(u32x4*)(WT + (size_t)(drow0 + n) * ldt + koff + k0 + 8 * c) = o; } }
    asm volatile("s_waitcnt lgkmcnt(0)" ::: "memory");
}
__device__ __forceinline__ void p0_weights(const Frame& F, const Args& a, int set, int gw, int NGW) {
    unsigned char* ws = a.ws;
    LAS float* scr = (LAS float*)(F.lds + F.wave * 16640);
    const float* w_in = a.in[2]; const float* w_a = a.in[9]; const float* w_b = a.in[10]; const float* w_out = a.in[11]; const float* g2 = a.in[12]; const float* w_gu = a.in[13]; const float* w_dn = a.in[14];
    constexpr int I_IN = (DM / 64) * (INW / 64), I_AB = (AW / 64) * (DM / 64), I_OUT = (DM / 64) * (DM / 64), I_GU = (DM / 64) * (2 * DFF / 64), I_DN = (DFF / 64) * (DM / 64);
    if (set == 0) {
        for (int it = gw; it < I_IN + I_GU; it += NGW) {
            int r = it;
            if (r < I_IN) { const int nb = INW / 64, kb = r / nb, n0 = (r % nb) * 64;
                const int gt = n0 >> 8, nin = n0 & 255;
                if (gt == 11 || gt >= 17) p0_transpose_item<true>(w_in, INW, kb * 64, n0, (bf16*)(ws + WS_WIN8), DM, (gt == 11 ? 0 : gt - 16) * 256 + nin, 0, nullptr, scr, F.lane);
                else p0_transpose_item(w_in, INW, kb * 64, n0, (bf16*)(ws + WS_WIN), DM, (gt < 11 ? gt : gt - 1) * 256 + nin, 0, nullptr, scr, F.lane);
                continue; } r -= I_IN;
            { const int nb = 2 * DFF / 64, kb = r / nb, n0 = (r % nb) * 64;
              const int j = n0 < DFF ? n0 : n0 - DFF, drow = (j / 128) * 256 + (n0 < DFF ? 0 : 128) + (j % 128);
              p0_transpose_item(w_gu, 2 * DFF, kb * 64, n0, (bf16*)(ws + WS_WGU), DM, drow, 0, g2, scr, F.lane); }
        }
    } else {
        for (int it = gw; it < 2 * I_AB + I_OUT + I_DN; it += NGW) {
            int r = it;
            if (r < I_AB) { const int nb = DM / 64, kb = r / nb, n0 = (r % nb) * 64; p0_transpose_item<(P4_FP8 != 0)>(w_a, DM, kb * 64, n0, (bf16*)(ws + WS_WAB), DM, n0, 0, nullptr, scr, F.lane); continue; } r -= I_AB;
            if (r < I_AB) { const int nb = DM / 64, kb = r / nb, n0 = (r % nb) * 64; p0_transpose_item<(P4_FP8 != 0)>(w_b, DM, kb * 64, n0, (bf16*)(ws + WS_WAB), DM, n0, AW, nullptr, scr, F.lane); continue; } r -= I_AB;
            if (r < I_OUT) { const int nb = DM / 64, kb = r / nb, n0 = (r % nb) * 64; p0_transpose_item<true>(w_out, DM, kb * 64, n0, (bf16*)(ws + WS_WOUT), DM, n0, 0, nullptr, scr, F.lane); continue; } r -= I_OUT;
            { const int nb = DM / 64, kb = r / nb, n0 = (r % nb) * 64; p0_transpose_item(w_dn, DM, kb * 64, n0, (bf16*)(ws + WS_WDN), DFF, n0, 0, nullptr, scr, F.lane); }
        }
    }
}
__device__ __forceinline__ void p0_prologue(const Frame& F_, const Args& a, int part) {
    Frame F = F_; F.lane = fresh_lane(); F.tid = F.wave * 64 + F.lane;
    unsigned char* ws = a.ws;
    const int gw = F.vcu * NWAVES + F.wave, NGW = F.G * NWAVES;
    if (part & 1) p0_weights(F, a, 0, gw, NGW);
    if (part & 4) p0_weights(F, a, 1, gw, NGW);
    const float* x = a.in[0]; const float* g1 = a.in[1]; bf16* XN = (bf16*)(ws + WS_RA); unsigned char* XN8 = (unsigned char*)a.out;
    f32x4 gv[8];
#pragma unroll
    for (int j = 0; j < 8; ++j) gv[j] = *((const f32x4*)g1 + F.lane + 64 * j);
    f32x4 vn[8];
    if (!(part & 2)) return;
    if (gw < M) {
#pragma unroll
        for (int j = 0; j < 8; ++j) vn[j] = __builtin_nontemporal_load((const f32x4*)(x + (size_t)gw * DM) + F.lane + 64 * j);
    }
    for (int m = gw; m < M; m += NGW) {
        f32x4 v[8]; float s = 0.f;
#pragma unroll
        for (int j = 0; j < 8; ++j) v[j] = vn[j];
        if (m + NGW < M) {
#pragma unroll
            for (int j = 0; j < 8; ++j) vn[j] = __builtin_nontemporal_load((const f32x4*)(x + (size_t)(m + NGW) * DM) + F.lane + 64 * j);
        }
#pragma unroll
        for (int j = 0; j < 8; ++j) s += (v[j][0] * v[j][0] + v[j][1] * v[j][1]) + (v[j][2] * v[j][2] + v[j][3] * v[j][3]);
        const float rs = __builtin_amdgcn_rsqf(wave_sum(s) * (1.f / DM) + EPS);
        u32x2* o8 = (u32x2*)(XN + (size_t)m * DM) + F.lane; unsigned* o4 = (unsigned*)(XN8 + (size_t)m * DM) + F.lane;
#pragma unroll
        for (int j = 0; j < 8; ++j) { const float y0 = v[j][0] * rs * gv[j][0], y1 = v[j][1] * rs * gv[j][1], y2 = v[j][2] * rs * gv[j][2], y3 = v[j][3] * rs * gv[j][3];
            u32x2 w; w.x = cvt_pk_bf16(y0, y1); w.y = cvt_pk_bf16(y2, y3); o8[64 * j] = w; o4[64 * j] = pg8::pk4_fp8(y0, y1, y2, y3); }
    }
    if (F.vcu == 0 && F.wave == 0) {
        const float* qna = a.in[3]; const float* kna = a.in[4]; const float* qnb = a.in[5]; const float* knb = a.in[6]; const float* rb = a.in[7]; const float* sinks = a.in[8];
        float* tbl = (float*)(ws + WS_TBL); const int l = F.lane;
        { float* gnt = (float*)(ws + WS_GNT); gnt[l] = qna[l]; gnt[64 + l] = qna[64 + l]; gnt[128 + l] = kna[l]; gnt[192 + l] = kna[64 + l]; gnt[256 + l] = qnb[l]; gnt[320 + l] = qnb[l]; gnt[384 + l] = knb[l]; gnt[448 + l] = knb[l]; }
        const float mqa = wave_max(fmaxf(fabsf(qna[l]), fabsf(qna[l + 64]))), mka = wave_max(fmaxf(fabsf(kna[l]), fabsf(kna[l + 64])));
        const float mqb = wave_max(fabsf(qnb[l])), mkb = wave_max(fabsf(knb[l]));
        for (int hh = 0; hh < NBH; ++hh) {
            const float mb = wave_max(rb[(l & 31) * NBH + hh]);
            float bl = (hh < AH ? 11.313708499f * mqa * mka : 8.f * mqb * mkb) + mb;
            if (hh >= AH) bl = fmaxf(bl, sinks[hh - AH]);
            const float BL2 = bl * LOG2E;
            for (int d = l; d <= 128; d += 64) tbl[hh * TBLW + d] = rb[t5_bucket(d) * NBH + hh] * LOG2E - BL2;
            if (l == 0) { tbl[hh * TBLW + 129] = -__builtin_inff(); tbl[hh * TBLW + 130] = hh >= AH ? __builtin_amdgcn_exp2f(sinks[hh - AH] * LOG2E - BL2) : 0.f; tbl[hh * TBLW + 131] = 0.f; }
        }
    }
}

__device__ __forceinline__ void p2_norm(const Frame& F_, const Args& a) {
    Frame F = F_; F.lane = fresh_lane(); F.tid = F.wave * 64 + F.lane;
    unsigned char* ws = a.ws;
    const int lane = F.lane, wave = F.wave;
    for (int u = F.vcu; u < 256; u += F.G) {
        const int type = u & 3, pm = u >> 2;
        if (type <= 2) {
            bf16* T = (bf16*)(ws + (type == 0 ? WS_QA : type == 1 ? WS_KA : WS_QB));
            const float* gn = a.in[type == 0 ? 3 : type == 1 ? 4 : 5];
            const int hd = type == 2 ? 64 : 128; const float qs = type == 0 ? 0.08838834764831845f * LOG2E : type == 2 ? 0.125f * LOG2E : 1.f;
            float gq[16];
#pragma unroll
            for (int j = 0; j < 16; ++j) gq[j] = gn[(lane * 16 + j) & (hd - 1)] * qs;
            float cs[16];
#pragma unroll
            for (int j = 0; j < 16; ++j) cs[j] = 0.f;
            for (int i = 0; i < 32; ++i) {
                bf16* p = T + (size_t)(pm * 256 + wave * 32 + i) * 1024 + lane * 16;
                const u32x4 w0 = *(const u32x4*)p, w1 = *(const u32x4*)(p + 8);
                float v[16];
#pragma unroll
                for (int j = 0; j < 4; ++j) { v[2 * j] = bf_lo(w0[j]); v[2 * j + 1] = bf_hi(w0[j]); v[8 + 2 * j] = bf_lo(w1[j]); v[9 + 2 * j] = bf_hi(w1[j]); }
                float ss = 0.f;
#pragma unroll
                for (int j = 0; j < 16; ++j) ss += v[j] * v[j];
                ss += __shfl_xor(ss, 1); ss += __shfl_xor(ss, 2); if (hd == 128) ss += __shfl_xor(ss, 4);
                const float rs = __builtin_amdgcn_rsqf(ss * (1.f / hd) + EPS);
#pragma unroll
                for (int j = 0; j < 16; ++j) { v[j] = v[j] * rs * gq[j]; cs[j] += v[j]; }
                u32x4 o0, o1;
#pragma unroll
                for (int j = 0; j < 4; ++j) { o0[j] = cvt_pk_bf16(v[2 * j], v[2 * j + 1]); o1[j] = cvt_pk_bf16(v[8 + 2 * j], v[9 + 2 * j]); }
                *(u32x4*)p = o0; *(u32x4*)(p + 8) = o1;
            }
            if (type == 1) {
                LAS float* red = (LAS float*)F.lds;
#pragma unroll
                for (int j = 0; j < 16; ++j) red[wave * 1024 + lane * 16 + j] = cs[j];
                __syncthreads();
                float* km = (float*)(ws + WS_KMEAN); const int b = pm / NBLK, n = pm % NBLK;
                for (int c = F.tid; c < 1024; c += 512) { float s = 0.f;
#pragma unroll
                    for (int w = 0; w < 8; ++w) s += red[w * 1024 + c];
                    km[(size_t)((b * AH + (c >> 7)) * NBLK + n) * AD + (c & 127)] = s * (1.f / LBLK); }
                __syncthreads();
            }
        } else {
            bf16* T = (bf16*)(ws + WS_KB); const float* gn = a.in[6];
            float gq[8];
#pragma unroll
            for (int j = 0; j < 8; ++j) gq[j] = gn[((lane & 7) * 8 + j)];
            for (int i = 0; i < 8; ++i) {
                bf16* p = T + (size_t)(pm * 256 + wave * 32 + i * 4 + (lane >> 4)) * 128 + (lane & 15) * 8;
                const u32x4 w0 = *(const u32x4*)p; float v[8];
#pragma unroll
                for (int j = 0; j < 4; ++j) { v[2 * j] = bf_lo(w0[j]); v[2 * j + 1] = bf_hi(w0[j]); }
                float ss = 0.f;
#pragma unroll
                for (int j = 0; j < 8; ++j) ss += v[j] * v[j];
                ss += __shfl_xor(ss, 1); ss += __shfl_xor(ss, 2); ss += __shfl_xor(ss, 4);
                const float rs = __builtin_amdgcn_rsqf(ss * (1.f / 64) + EPS);
                u32x4 o0;
#pragma unroll
                for (int j = 0; j < 4; ++j) o0[j] = cvt_pk_bf16(v[2 * j] * rs * gq[2 * j], v[2 * j + 1] * rs * gq[2 * j + 1]);
                *(u32x4*)p = o0;
            }
        }
    }
}

namespace att {
__device__ __forceinline__ int crow(int r, int hi) { return (r & 3) + 8 * (r >> 2) + 4 * hi; }
#define KSWZ(row, colB) ((row) * 256 + ((colB) ^ (((row) & 7) << 4)))
#define KSWZ64(row, colB) ((row) * 128 + ((colB) ^ (((row) & 7) << 4)))
__device__ __forceinline__ int v_off(int key, int d, int DB) { return ((key >> 3) * DB + (d >> 5)) * 512 + (key & 7) * 64 + (d & 31) * 2; }
typedef short v4i16_t __attribute__((ext_vector_type(4)));
__device__ __forceinline__ s16x4 vtr(const LAS unsigned char* p) { return __builtin_bit_cast(s16x4, __builtin_amdgcn_ds_read_tr16_b64_v4i16((LAS v4i16_t*)p)); }
__device__ __forceinline__ float swap_add(float v) { auto rr = __builtin_amdgcn_permlane32_swap(__float_as_uint(v), __float_as_uint(v), false, false); return __uint_as_float(rr[0]) + __uint_as_float(rr[1]); }
#define PK4(P, B_, OUT) do { unsigned a0 = cvt_pk_bf16(P[B_ + 0], P[B_ + 1]), a1 = cvt_pk_bf16(P[B_ + 2], P[B_ + 3]);                     \
        unsigned b0 = cvt_pk_bf16(P[B_ + 4], P[B_ + 5]), b1 = cvt_pk_bf16(P[B_ + 6], P[B_ + 7]);                                          \
        auto r0 = __builtin_amdgcn_permlane32_swap(a0, b0, false, false); auto r1 = __builtin_amdgcn_permlane32_swap(a1, b1, false, false); \
        u32x4 w = {r0[0], r1[0], r0[1], r1[1]}; OUT = __builtin_bit_cast(bf16x8, w); } while (0)

constexpr int A_V = 0, A_K = 32768, A_WS = 65536, A_TBL = 65536 + 2048, A_STG = 0;
constexpr int B_WS = 98304, B_TBL = 98304 + 2048, B_STG = 106496;

__device__ __forceinline__ void moba_unit(int tid, int b, int h, int qb, const bf16* QA, const bf16* KA, const bf16* VA, bf16* Y, const float* kmean, const float* tblg, LAS unsigned char* lds) {
    const int wid = __builtin_amdgcn_readfirstlane(tid >> 6), lane = tid & 63, r32 = lane & 31, hi = lane >> 5;
    LAS float* wsf = (LAS float*)(lds + A_WS) + wid * 64; LAS float* tbl = (LAS float*)(lds + A_TBL);
    const size_t rowbase = (size_t)b * SEQ;
    if (tid < TBLW) tbl[tid] = tblg[h * TBLW + tid];
    const bf16* Qw = QA + (rowbase + qb * LBLK + wid * 32 + r32) * AW + h * AD;
    bf16x8 qr[8];
#pragma unroll
    for (int d0 = 0; d0 < 8; ++d0) qr[d0] = *(const bf16x8*)(Qw + d0 * 16 + hi * 8);
    const bf16* Ksrc; const bf16* Vsrc;
    { const int krow = 8 * wid + (lane >> 4), kch = (lane & 15) ^ (krow & 7);
      const int vs = 4 * wid + (lane >> 5), vkey = (vs >> 2) * 8 + ((lane & 31) >> 2), vd = (vs & 3) * 32 + (lane & 3) * 8;
      Ksrc = KA + (rowbase + krow) * AW + h * AD + kch * 8; Vsrc = VA + (rowbase + vkey) * AW + h * AD + vd; }
    const int k1off = 4 * AW + ((((lane & 15) ^ ((8 * wid + (lane >> 4) + 4) & 7)) - ((lane & 15) ^ ((8 * wid + (lane >> 4)) & 7))) * 8);
#define DMA_TILE(t, bf) do { const size_t o_ = (size_t)(t) * 64 * AW; \
        __builtin_amdgcn_global_load_lds((const unsigned*)(Ksrc + o_), (LAS unsigned*)(lds + A_K + (bf) * 16384 + wid * 2048), 16, 0, 0); \
        __builtin_amdgcn_global_load_lds((const unsigned*)(Ksrc + o_ + k1off), (LAS unsigned*)(lds + A_K + (bf) * 16384 + wid * 2048 + 1024), 16, 0, 0); \
        __builtin_amdgcn_global_load_lds((const unsigned*)(Vsrc + o_), (LAS unsigned*)(lds + A_V + (bf) * 16384 + wid * 2048), 16, 0, 0); \
        __builtin_amdgcn_global_load_lds((const unsigned*)(Vsrc + o_ + 64), (LAS unsigned*)(lds + A_V + (bf) * 16384 + wid * 2048 + 1024), 16, 0, 0); } while (0)
    unsigned selmask = 0u;
    if (qb > 0) {
        f32x16 g = f32x16{};
        const float* kmr = kmean + (size_t)((b * AH + h) * NBLK + (r32 & 15)) * AD + hi * 8;
#pragma unroll
        for (int d0 = 0; d0 < 8; ++d0) {
            const f32x4 ka = *(const f32x4*)(kmr + d0 * 16), kb = *(const f32x4*)(kmr + d0 * 16 + 4);
            u32x4 hw, lw;
            hw.x = cvt_pk_bf16(ka[0], ka[1]); hw.y = cvt_pk_bf16(ka[2], ka[3]); hw.z = cvt_pk_bf16(kb[0], kb[1]); hw.w = cvt_pk_bf16(kb[2], kb[3]);
            lw.x = cvt_pk_bf16(ka[0] - bf_lo(hw.x), ka[1] - bf_hi(hw.x)); lw.y = cvt_pk_bf16(ka[2] - bf_lo(hw.y), ka[3] - bf_hi(hw.y));
            lw.z = cvt_pk_bf16(kb[0] - bf_lo(hw.z), kb[1] - bf_hi(hw.z)); lw.w = cvt_pk_bf16(kb[2] - bf_lo(hw.w), kb[3] - bf_hi(hw.w));
            g = __builtin_amdgcn_mfma_f32_32x32x16_bf16(__builtin_bit_cast(bf16x8, hw), qr[d0], g, 0, 0, 0);
            g = __builtin_amdgcn_mfma_f32_32x32x16_bf16(__builtin_bit_cast(bf16x8, lw), qr[d0], g, 0, 0, 0);
        }
        float G[16];
#pragma unroll
        for (int r = 0; r < 8; ++r) {
            auto rr = __builtin_amdgcn_permlane32_swap(__float_as_uint(g[r]), __float_as_uint(g[r]), false, false);
            const float other = hi ? __uint_as_float(rr[0]) : __uint_as_float(rr[1]);
            const int nlo = (r & 3) + 8 * (r >> 2);
            G[nlo] = hi ? other : g[r]; G[nlo + 4] = hi ? g[r] : other;
        }
#pragma unroll
        for (int n = 0; n < 16; ++n) G[n] = (n < qb) ? G[n] : -__builtin_inff();
#pragma unroll
        for (int pass = 0; pass < 3; ++pass) {
            float best = -__builtin_inff(); int bi = 16;
#pragma unroll
            for (int n = 0; n < 16; ++n) { const bool c = !((selmask >> n) & 1u) && (G[n] > best); best = c ? G[n] : best; bi = c ? n : bi; }
            selmask |= (bi < 16) ? (1u << bi) : 0u;
        }
    }
    DMA_TILE(0, 0);
    __syncthreads();
    const int NT = 4 * (qb + 1);
    const int qw0 = qb * LBLK + wid * 32;
    const float c128 = tbl[128];
    float l_reg = 0.f; f32x16 o[4];
#pragma unroll
    for (int d = 0; d < 4; ++d) o[d] = f32x16{};
    const int vrb = hi * 4 * 512 + ((lane & 15) >> 2) * 64 + ((lane >> 4) & 1) * 32 + (lane & 3) * 8;
    for (int t = 0; t < NT; ++t) {
        const int cur = t & 1;
        if (t + 1 < NT) DMA_TILE(t + 1, cur ^ 1);
        const int k0 = t * 64, n = t >> 2;
        const bool active = (k0 <= qw0 + 31);
        if (active) {
            f32x16 p0 = f32x16{}, p1 = f32x16{};
            {   const LAS unsigned char* Kb = lds + A_K + cur * 16384;
                const LAS unsigned char* kb[4];
#pragma unroll
                for (int dd = 0; dd < 4; ++dd) kb[dd] = Kb + KSWZ(r32, (dd * 16 + hi * 8) * 2);
#pragma unroll
                for (int d0 = 0; d0 < 8; ++d0) { const LAS unsigned char* ap = kb[d0 & 3] + (d0 >> 2) * 128;
                    const bf16x8 b0 = *(const LAS bf16x8*)ap, b1 = *(const LAS bf16x8*)(ap + 32 * 256);
                    p0 = __builtin_amdgcn_mfma_f32_32x32x16_bf16(b0, qr[d0], p0, 0, 0, 0);
                    p1 = __builtin_amdgcn_mfma_f32_32x32x16_bf16(b1, qr[d0], p1, 0, 0, 0);
                    if (d0 == 3) __builtin_amdgcn_sched_barrier(0); } }
            const bool sel = (n == qb) || ((selmask >> n) & 1u);
            const bool nearb = (qw0 - (k0 + 63) < 128);
            if (nearb) {
                int dq = qw0 + r32 - k0 - 4 * hi;
                asm volatile("" : "+v"(dq));
#pragma unroll
                for (int r = 0; r < 16; ++r) { const int c = (r & 3) + 8 * (r >> 2);
                    const int d0_ = dq - c, d1_ = dq - c - 32;
                    const int x0 = (d0_ < 0 || !sel) ? 129 : (d0_ > 128 ? 128 : d0_), x1 = (d1_ < 0 || !sel) ? 129 : (d1_ > 128 ? 128 : d1_);
                    p0[r] = __builtin_amdgcn_exp2f(p0[r] + tbl[x0]); p1[r] = __builtin_amdgcn_exp2f(p1[r] + tbl[x1]);
                    if ((r & 3) == 3) __builtin_amdgcn_sched_barrier(0); }
            } else {
                const float ca = sel ? c128 : -__builtin_inff();
#pragma unroll
                for (int r = 0; r < 16; ++r) { p0[r] = __builtin_amdgcn_exp2f(p0[r] + ca); p1[r] = __builtin_amdgcn_exp2f(p1[r] + ca); }
            }
            float ps = 0.f;
#pragma unroll
            for (int r = 0; r < 16; ++r) ps += p0[r];
#pragma unroll
            for (int r = 0; r < 16; ++r) ps += p1[r];
            l_reg += ps;
            bf16x8 pa0, pa1, pa2, pa3;
            PK4(p0, 0, pa0); PK4(p0, 8, pa1); PK4(p1, 0, pa2); PK4(p1, 8, pa3);
            const LAS unsigned char* Vb = lds + A_V + cur * 16384 + vrb;
#pragma unroll
            for (int d0 = 0; d0 < 4; ++d0) {
#define VFRAG(ks) ({ const s16x4 lo_ = vtr(Vb + (2 * (ks) * 4 + d0) * 512), hi_ = vtr(Vb + (2 * (ks) * 4 + d0) * 512 + 256); (bf16x8){lo_[0], lo_[1], lo_[2], lo_[3], hi_[0], hi_[1], hi_[2], hi_[3]}; })
                o[d0] = __builtin_amdgcn_mfma_f32_32x32x16_bf16(pa0, VFRAG(0), o[d0], 0, 0, 0);
                o[d0] = __builtin_amdgcn_mfma_f32_32x32x16_bf16(pa1, VFRAG(1), o[d0], 0, 0, 0);
                o[d0] = __builtin_amdgcn_mfma_f32_32x32x16_bf16(pa2, VFRAG(2), o[d0], 0, 0, 0);
                o[d0] = __builtin_amdgcn_mfma_f32_32x32x16_bf16(pa3, VFRAG(3), o[d0], 0, 0, 0);
#undef VFRAG
            }
        }
        __syncthreads();
    }
    l_reg = swap_add(l_reg);
    int lane_e = lane; asm volatile("" : "+v"(lane_e));
    const int r32e = lane_e & 31, hie = lane_e >> 5;
    if (hie == 0) wsf[r32e] = l_reg;
    asm volatile("s_waitcnt lgkmcnt(0)" ::: "memory");
#if P4_FP8
    LAS unsigned char* stg = lds + A_STG + wid * 4096;
    { LAS unsigned char* sp = stg + (4 * hie) * 128 + r32e; const LAS float* wl = wsf + 4 * hie;
#pragma unroll
    for (int r = 0; r < 16; ++r) { const int oc = (r & 3) + 8 * (r >> 2); const float rl = __builtin_amdgcn_rcpf(wl[oc]) * 16.f;
#pragma unroll
        for (int d0 = 0; d0 < 4; ++d0) sp[oc * 128 + d0 * 32] = (unsigned char)__builtin_amdgcn_cvt_pk_fp8_f32(o[d0][r] * rl, 0.f, 0, false); } }
    asm volatile("s_waitcnt lgkmcnt(0)" ::: "memory");
    unsigned char* Yw = (unsigned char*)Y + (rowbase + qb * LBLK + wid * 32) * DM + h * AD;
#pragma unroll
    for (int i = 0; i < 4; ++i) { const int row = i * 8 + (lane_e >> 3), ch = lane_e & 7; *(u32x4*)(Yw + (size_t)row * DM + ch * 16) = *(const LAS u32x4*)(stg + row * 128 + ch * 16); }
#else
    LAS bf16* stg = (LAS bf16*)(lds + A_STG + wid * 8192);
    { LAS bf16* sp = stg + (4 * hie) * 128 + r32e; const LAS float* wl = wsf + 4 * hie;
#pragma unroll
    for (int r = 0; r < 16; ++r) { const int oc = (r & 3) + 8 * (r >> 2); const float rl = __builtin_amdgcn_rcpf(wl[oc]);
#pragma unroll
        for (int d0 = 0; d0 < 4; ++d0) sp[oc * 128 + d0 * 32] = (bf16)(cvt_pk_bf16(o[d0][r] * rl, 0.f) & 0xffffu); } }
    asm volatile("s_waitcnt lgkmcnt(0)" ::: "memory");
    bf16* Yw = Y + (rowbase + qb * LBLK + wid * 32) * DM + h * AD;
#pragma unroll
    for (int i = 0; i < 8; ++i) { const int row = i * 4 + (lane_e >> 4), ch = lane_e & 15; *(u32x4*)(Yw + (size_t)row * DM + ch * 8) = *(const LAS u32x4*)(stg + row * 128 + ch * 8); }
#endif
    __syncthreads();
#undef DMA_TILE
}

__device__ __forceinline__ void swa_dma(int tid, int b, int kvh, int tq, const bf16* KB_, const bf16* VB_, LAS unsigned char* lds, int buf) {
    const int wid = __builtin_amdgcn_readfirstlane(tid >> 6), lane = tid & 63, t0 = tq * 64;
    const size_t rowbase = (size_t)b * SEQ;
#pragma unroll
    for (int i = 0; i < 3; ++i) { const int p = wid * 3 + i, key0 = t0 - 128 + 8 * p;
        if (key0 >= 0) {
            const int kr = lane >> 3, kch = (lane & 7) ^ ((8 * p + kr) & 7);
            __builtin_amdgcn_global_load_lds((const unsigned*)(KB_ + (rowbase + key0 + kr) * BKW + kvh * BD + kch * 8), (LAS unsigned*)(lds + buf * 49152 + p * 1024), 16, 0, 0);
            const int vk = (lane & 31) >> 2, vd = (lane >> 5) * 32 + (lane & 3) * 8;
            __builtin_amdgcn_global_load_lds((const unsigned*)(VB_ + (rowbase + key0 + vk) * BKW + kvh * BD + vd), (LAS unsigned*)(lds + buf * 49152 + 24576 + p * 1024), 16, 0, 0);
        } }
}
__device__ __forceinline__ void swa_compute(int tid, int b, int kvh, int tq, const bf16* QB_, bf16* Y, const float* tblg, LAS unsigned char* lds, int buf) {
    const int wid = __builtin_amdgcn_readfirstlane(tid >> 6), lane = tid & 63, r32 = lane & 31, hi = lane >> 5;
    const int hq = kvh * 8 + wid, t0 = tq * 64, c_lo = tq >= 2 ? 0 : 4 - 2 * tq;
    const size_t rowbase = (size_t)b * SEQ;
    LAS float* wsf = (LAS float*)(lds + B_WS) + wid * 64; LAS float* tbl = (LAS float*)(lds + B_TBL) + wid * TBLW;
    const LAS unsigned char* Kl = lds + buf * 49152; const LAS unsigned char* Vl = Kl + 24576;
    for (int i = lane; i < TBLW; i += 64) tbl[i] = tblg[(AH + hq) * TBLW + i];
    bf16x8 qr[2][4];
#pragma unroll
    for (int j = 0; j < 2; ++j)
#pragma unroll
        for (int d0 = 0; d0 < 4; ++d0) qr[j][d0] = *(const bf16x8*)(QB_ + (rowbase + t0 + 32 * j + r32) * BW + hq * BD + d0 * 16 + hi * 8);
    asm volatile("s_waitcnt lgkmcnt(0)" ::: "memory");
    const int vrb = hi * 2 * 512 + ((lane & 15) >> 2) * 64 + ((lane >> 4) & 1) * 32 + (lane & 3) * 8;
    const float sinkw = tbl[130];
#pragma unroll
    for (int j = 0; j < 2; ++j) {
        float l_reg = 0.f; f32x16 o[2]; o[0] = f32x16{}; o[1] = f32x16{};
#pragma unroll
        for (int cc = 0; cc < 5; ++cc) {
            const int c = cc + j;
            if (c >= c_lo) {
                f32x16 p0 = f32x16{};
#pragma unroll
                for (int d0 = 0; d0 < 4; ++d0) { const bf16x8 kf = *(const LAS bf16x8*)(Kl + KSWZ64(c * 32 + r32, (d0 * 16 + hi * 8) * 2));
                    p0 = __builtin_amdgcn_mfma_f32_32x32x16_bf16(kf, qr[j][d0], p0, 0, 0, 0); }
                int dq = 128 + r32 - 32 * cc - 4 * hi; float ps = 0.f;
                asm volatile("" : "+v"(dq));
#pragma unroll
                for (int r = 0; r < 16; ++r) { const int d_ = dq - ((r & 3) + 8 * (r >> 2)); const int x = (d_ < 0 || d_ >= WIN) ? 129 : d_;
                    p0[r] = __builtin_amdgcn_exp2f(p0[r] + tbl[x]); ps += p0[r]; }
                l_reg += ps;
                bf16x8 pa0, pa1; PK4(p0, 0, pa0); PK4(p0, 8, pa1);
                const LAS unsigned char* Vb = Vl + vrb + c * 4 * 1024;
#pragma unroll
                for (int d0 = 0; d0 < 2; ++d0) {
#define VFRAG(ks) ({ const s16x4 lo_ = vtr(Vb + (2 * (ks) * 2 + d0) * 512), hi_ = vtr(Vb + (2 * (ks) * 2 + d0) * 512 + 256); (bf16x8){lo_[0], lo_[1], lo_[2], lo_[3], hi_[0], hi_[1], hi_[2], hi_[3]}; })
                    o[d0] = __builtin_amdgcn_mfma_f32_32x32x16_bf16(pa0, VFRAG(0), o[d0], 0, 0, 0);
                    o[d0] = __builtin_amdgcn_mfma_f32_32x32x16_bf16(pa1, VFRAG(1), o[d0], 0, 0, 0);
#undef VFRAG
                }
            }
        }
        l_reg = swap_add(l_reg) + sinkw;
        if (hi == 0) wsf[r32] = l_reg;
        asm volatile("s_waitcnt lgkmcnt(0)" ::: "memory");
#if P4_FP8
        LAS unsigned char* stg = lds + B_STG + wid * 2048;
        { LAS unsigned char* sp = stg + (4 * hi) * 64 + r32; const LAS float* wl = wsf + 4 * hi;
#pragma unroll
        for (int r = 0; r < 16; ++r) { const int oc = (r & 3) + 8 * (r >> 2); const float rl = __builtin_amdgcn_rcpf(wl[oc]) * 16.f;
#pragma unroll
            for (int d0 = 0; d0 < 2; ++d0) sp[oc * 64 + d0 * 32] = (unsigned char)__builtin_amdgcn_cvt_pk_fp8_f32(o[d0][r] * rl, 0.f, 0, false); } }
        asm volatile("s_waitcnt lgkmcnt(0)" ::: "memory");
        unsigned char* Yw = (unsigned char*)Y + (rowbase + t0 + 32 * j) * DM + AW + hq * BD;
#pragma unroll
        for (int i = 0; i < 2; ++i) { const int row = i * 16 + (lane >> 2), ch = lane & 3; *(u32x4*)(Yw + (size_t)row * DM + ch * 16) = *(const LAS u32x4*)(stg + row * 64 + ch * 16); }
#else
        LAS bf16* stg = (LAS bf16*)(lds + B_STG + wid * 4096);
        { LAS bf16* sp = stg + (4 * hi) * 64 + r32; const LAS float* wl = wsf + 4 * hi;
#pragma unroll
        for (int r = 0; r < 16; ++r) { const int oc = (r & 3) + 8 * (r >> 2); const float rl = __builtin_amdgcn_rcpf(wl[oc]);
#pragma unroll
            for (int d0 = 0; d0 < 2; ++d0) sp[oc * 64 + d0 * 32] = (bf16)(cvt_pk_bf16(o[d0][r] * rl, 0.f) & 0xffffu); } }
        asm volatile("s_waitcnt lgkmcnt(0)" ::: "memory");
        bf16* Yw = Y + (rowbase + t0 + 32 * j) * DM + AW + hq * BD;
#pragma unroll
        for (int i = 0; i < 4; ++i) { const int row = i * 8 + (lane >> 3), ch = lane & 7; *(u32x4*)(Yw + (size_t)row * DM + ch * 8) = *(const LAS u32x4*)(stg + row * 64 + ch * 8); }
#endif
        asm volatile("s_waitcnt lgkmcnt(0)" ::: "memory");
    }
}
}

__device__ __forceinline__ void p3_attention(const Frame& F, const Args& a) {
    unsigned char* ws = a.ws;
    const bf16* QA = (const bf16*)(ws + WS_QA); const bf16* KA = (const bf16*)(ws + WS_KA); const bf16* VA = (const bf16*)(ws + WS_VA);
    const bf16* QB_ = (const bf16*)(ws + WS_QB); const bf16* KB_ = (const bf16*)(ws + WS_KB); const bf16* VB_ = (const bf16*)(ws + WS_VB);
    bf16* Y = (bf16*)(ws + WS_RB); const float* kmean = (const float*)(ws + WS_KMEAN); const float* tblg = (const float*)(ws + WS_TBL);
    const int tid = F.wave * 64 + fresh_lane();
#ifndef NO_MOBA
    for (int p = F.vcu; p < 256; p += F.G) {
        const int bh = p >> 3, s = p & 7;
#pragma unroll 1
        for (int e = 0; e < 2; ++e) att::moba_unit(tid, bh >> 3, bh & 7, e ? s : 15 - s, QA, KA, VA, Y, kmean, tblg, F.lds);
    }
#endif
#ifndef NO_SWA
    { int u = F.vcu, bufi = 0;
      if (u < 512) att::swa_dma(tid, u >> 7, (u >> 6) & 1, u & 63, KB_, VB_, F.lds, 0);
      __syncthreads();
      for (; u < 512; u += F.G) {
          const int un = u + F.G;
          if (un < 512) att::swa_dma(tid, un >> 7, (un >> 6) & 1, un & 63, KB_, VB_, F.lds, bufi ^ 1);
          att::swa_compute(tid, u >> 7, (u >> 6) & 1, u & 63, QB_, Y, tblg, F.lds, bufi);
          __syncthreads(); bufi ^= 1;
      } }
#endif
}


#define XB_TMO      128
#define XB_XCNT(j)  (256  + 64 * (j))
#define XB_XSUB(j)  (1280 + 64 * (j))
#define XB_XGEN(j)  (2304 + 64 * (j))
#define XB_TOP      3328
#define XB_TOPGEN   3392
#define XCD_BAR_WORDS 3456
#define XB_SPIN_CAP (1u << 18)
__device__ __forceinline__ unsigned xb_ld(unsigned* p)              { return __hip_atomic_load(p, __ATOMIC_RELAXED, __HIP_MEMORY_SCOPE_AGENT); }
__device__ __forceinline__ unsigned xb_add(unsigned* p, unsigned v) { return __hip_atomic_fetch_add(p, v, __ATOMIC_RELAXED, __HIP_MEMORY_SCOPE_AGENT); }
__device__ __forceinline__ unsigned xb_xcc_id() { return (unsigned)__builtin_amdgcn_s_getreg((3 << 11) | 20) & 0xFu; }
#define XB_SPIN(cond, bar) do { unsigned _sp = 0; while (cond) { __builtin_amdgcn_s_sleep(1); \
    if ((++_sp & 255u) == 0u) { if (xb_ld(&(bar)[XB_TMO])) break; if (_sp > XB_SPIN_CAP) { atomicAdd(&(bar)[XB_TMO], 1u); break; } } } } while (0)
struct XcdBarrier { unsigned* bar; unsigned x; volatile LAS unsigned* st; };
__device__ __forceinline__ XcdBarrier xcd_barrier_post(unsigned* bar, volatile LAS unsigned* st) {
    XcdBarrier b; b.bar = bar; b.x = xb_xcc_id(); b.st = st;
    if (threadIdx.x == 0) (void)xb_add(&bar[XB_XCNT(b.x)], 1u);
    return b;
}
__device__ __forceinline__ void xcd_barrier_complete(unsigned* bar, unsigned x, unsigned& nloc, unsigned& nx) {
    const unsigned G = gridDim.x * gridDim.y * gridDim.z;
    unsigned sum, cnt, mine, sp = 0u;
    for (;;) {
        sum = 0u; cnt = 0u; mine = 0u;
#pragma unroll
        for (unsigned j = 0; j < 16; ++j) { const unsigned c = xb_ld(&bar[XB_XCNT(j)]); sum += c; cnt += (c > 0u) ? 1u : 0u; mine = (j == x) ? c : mine; }
        if (sum == G) break;
        __builtin_amdgcn_s_sleep(1);
        if ((++sp & 255u) == 0u) { if (xb_ld(&bar[XB_TMO])) break; if (sp > XB_SPIN_CAP) { atomicAdd(&bar[XB_TMO], 1u); break; } }
    }
    nloc = mine > 0u ? mine : 1u; nx = cnt > 0u ? cnt : 1u;
}
__device__ __forceinline__ void xcd_barrier(const XcdBarrier& b) {
    asm volatile("s_waitcnt vmcnt(0)" ::: "memory");
    __syncthreads();
    if (threadIdx.x == 0) {
        unsigned* bar = b.bar;
        __builtin_amdgcn_s_waitcnt(0);
        unsigned nloc = b.st[0], nx = b.st[1];
        if (nloc == 0u) { xcd_barrier_complete(bar, b.x, nloc, nx); b.st[0] = nloc; b.st[1] = nx; }
        const unsigned old = xb_add(&bar[XB_XSUB(b.x)], 1u);
        const unsigned gen = old / nloc;
        if (old + 1u == (gen + 1u) * nloc) {
            __builtin_amdgcn_fence(__ATOMIC_RELEASE, "agent");
            asm volatile("s_waitcnt vmcnt(0)" ::: "memory");
            const unsigned og = xb_add(&bar[XB_TOP], 1u);
            const unsigned tg = og / nx;
            if (og + 1u == (tg + 1u) * nx) xb_add(&bar[XB_TOPGEN], 1u);
            else XB_SPIN(xb_ld(&bar[XB_TOPGEN]) == tg, bar);
            __builtin_amdgcn_fence(__ATOMIC_ACQUIRE, "agent");
            xb_add(&bar[XB_XGEN(b.x)], 1u);
            asm volatile("s_waitcnt vmcnt(0)" ::: "memory");
        } else {
            XB_SPIN(xb_ld(&bar[XB_XGEN(b.x)]) == gen, bar);
            __builtin_amdgcn_fence(__ATOMIC_ACQUIRE, "agent");
            asm volatile("s_waitcnt vmcnt(0)" ::: "memory");
        }
    }
    __syncthreads();
}

__global__ void __launch_bounds__(NWAVES * 64, 2) fwd_kernel(Args args) {
    extern __shared__ __attribute__((aligned(16))) unsigned char lds_raw[];
    Frame F;
    F.lds = (LAS unsigned char*)lds_raw;
    F.tid = threadIdx.x; F.lane = F.tid & 63; F.wave = __builtin_amdgcn_readfirstlane((int)threadIdx.x >> 6);
    F.G = gridDim.x; { const int bx = blockIdx.x; F.vcu = (F.G % 8 == 0) ? (bx % 8) * (F.G / 8) + bx / 8 : bx; }
    unsigned char* ws = args.ws;
    const int lo = args.ph_lo, hi = args.ph_hi;
    int cg_id = (int)blockIdx.x;
    volatile LAS unsigned* misc = (volatile LAS unsigned*)(F.lds + LDS_BYTES - 256);
    XcdBarrier xbar; xbar.bar = (unsigned*)(ws + WS_BAR); xbar.x = 0; xbar.st = misc + 8;
    if (args.coop) { if (F.tid == 0) { misc[8] = 0u; misc[9] = 0u; } xbar = xcd_barrier_post((unsigned*)(ws + WS_BAR), misc + 8); }
    if (args.coop && F.tid == 0) {
        const unsigned xcc = (unsigned)__builtin_amdgcn_s_getreg((3 << 11) | 20) & 0xFu;
        misc[0] = xcc; misc[1] = __hip_atomic_fetch_add((unsigned*)(ws + WS_BAR) + 3584 + 32 * xcc, 1u, __ATOMIC_RELAXED, __HIP_MEMORY_SCOPE_AGENT);
    }
#ifndef PHMASK
#define PHMASK 0xff
#endif
#ifndef DUP_PHASE
#define DUP_PHASE -1
#endif
#define IN(k) (((PHMASK >> (k)) & 1) && lo <= (k) && (k) < hi)
#define SEAM(k) do { if (IN(k) && IN((k) + 1)) { if (args.coop) xcd_barrier(xbar); } } while (0)
    const bool defer_w = DEFER_W && F.G == 256;
    if (IN(0)) { p0_prologue(F, args, defer_w ? 3 : 7); } SEAM(0);
    if (args.coop) {
        if (F.wave == 0 && fresh_lane() == 0) {
            const unsigned xcc = misc[0], rank = misc[1]; bool ok = (F.G % 8 == 0) && xcc < 8u;
            for (unsigned j = 0; j < 16; ++j) { const unsigned c = __hip_atomic_load((unsigned*)(ws + WS_BAR) + 3584 + 32 * j, __ATOMIC_RELAXED, __HIP_MEMORY_SCOPE_AGENT); ok = ok && (c == (j < 8u ? (unsigned)F.G / 8u : 0u)); }
            misc[2] = ok ? rank * 8u + xcc : (unsigned)blockIdx.x;
            misc[3] = ok ? xcc * ((unsigned)F.G / 8u) + rank : (unsigned)F.vcu;
        }
        __syncthreads();
        cg_id = (int)misc[2]; F.vcu = (int)misc[3];
        cg_id = __builtin_amdgcn_readfirstlane(cg_id); F.vcu = __builtin_amdgcn_readfirstlane(F.vcu);
    }
    if (IN(1)) {
        { pg8::Gemm g{(const bf16*)(ws + WS_RA), (const bf16*)(ws + WS_WIN), M, 4096, DM}; pg8::StaticOrder S; S.init(M, 4096, F.G, cg_id);
          pg8::EpiProjNorm E{ws, F.lds + RING_BYTES};
          pg8::gemm_phase<pg8::EpiProjNorm, pg8::StaticOrder, true, false>(F.lds, g, S, E, F.wave); }
        { pg8::Gemm g{(const bf16*)args.out, (const bf16*)(ws + WS_WIN8), M, 4352, DM}; pg8::StaticOrder S; S.init(M, 4352, F.G, cg_id);
          pg8::EpiProj E{(bf16*)(ws + WS_QA), (bf16*)(ws + WS_KA), (bf16*)(ws + WS_VA), (bf16*)(ws + WS_QB), (bf16*)(ws + WS_KB), (bf16*)(ws + WS_VB), (bf16*)(ws + WS_G), 1, 1.f / 32.f};
          pg8::gemm_phase<pg8::EpiProj, pg8::StaticOrder, true, true>(F.lds, g, S, E, F.wave);
          if (defer_w) { pg8::Unit u5;
              if (!S.next(4, u5)) { Frame F2 = F; F2.lane = fresh_lane(); F2.tid = F2.wave * 64 + F2.lane;
                  const int nbusy = 17 * 64 - 4 * F.G, nidle = F.G - nbusy, rank = cg_id - nbusy;
                  p0_weights(F2, args, 1, rank * NWAVES + F.wave, nidle * NWAVES); } } }
    } SEAM(1);
    if (IN(3)) { for (int rep = 0; rep < (DUP_PHASE == 3 ? 2 : 1); ++rep) p3_attention(F, args); } SEAM(3);
    if (IN(4)) {
        pg8::Gemm g{(const bf16*)(ws + WS_RB), (const bf16*)(ws + WS_WAB), M, DM, DM}; pg8::StaticOrder S; S.init(M, DM, F.G, cg_id);
        pg8::EpiMerge E{(const bf16*)(ws + WS_G), (bf16*)(ws + WS_RA)};
        for (int rep = 0; rep < (DUP_PHASE == 4 ? 2 : 1); ++rep)
        pg8::gemm_phase<pg8::EpiMerge, pg8::StaticOrder, true, (P4_FP8 != 0)>(F.lds, g, S, E, F.wave);
    } SEAM(4);
    if (IN(5)) {
        pg8::Gemm g{(const bf16*)(ws + WS_RA), (const bf16*)(ws + WS_WOUT), M, DM, DM}; pg8::StaticOrder S; S.init(M, DM, F.G, cg_id);
        pg8::EpiOut E{args.in[0], args.out, (bf16*)(ws + WS_RB), (float*)(ws + WS_ROWSS)};
        for (int rep = 0; rep < (DUP_PHASE == 5 ? 2 : 1); ++rep)
        pg8::gemm_phase<pg8::EpiOut, pg8::StaticOrder, true, true>(F.lds, g, S, E, F.wave);
    } SEAM(5);
    if (IN(6)) {
        pg8::Gemm g{(const bf16*)(ws + WS_RB), (const bf16*)(ws + WS_WGU), M, 2 * DFF, DM}; pg8::StaticOrder S; S.init(M, 2 * DFF, F.G, cg_id);
        pg8::EpiGU E{(const float*)(ws + WS_ROWSS), (bf16*)(ws + WS_ACT)};
        for (int rep = 0; rep < (DUP_PHASE == 6 ? 2 : 1); ++rep)
        pg8::gemm_phase<pg8::EpiGU, pg8::StaticOrder, true>(F.lds, g, S, E, F.wave);
    } SEAM(6);
    if (IN(7)) {
        pg8::Gemm g{(const bf16*)(ws + WS_ACT), (const bf16*)(ws + WS_WDN), M, DM, DFF}; pg8::StaticOrder S; S.init(M, DM, F.G, cg_id);
        pg8::EpiDown E{(const bf16*)(ws + WS_RB), args.out};
        pg8::gemm_phase<pg8::EpiDown, pg8::StaticOrder, true>(F.lds, g, S, E, F.wave);
    }
#undef IN
#undef SEAM
}

extern "C" void kernel_launch(void* const* d_in, const int* in_sizes, int n_in, void* d_out, int out_size, void* d_ws, size_t ws_size, hipStream_t stream) {
    static int grid = 0;
    if (grid == 0) {
        if (n_in != 15 || in_sizes[0] != M * DM || out_size != M * DM || ws_size < WS_END) {
            fprintf(stderr, "kernel_launch: unexpected shapes (n_in %d, in0 %d, out %d, ws %zu need %zu); nothing launched\n", n_in, n_in > 0 ? in_sizes[0] : -1, out_size, ws_size, (size_t)WS_END); grid = -1; return; }
        int dev = 0, cus = 0, per_cu = 0;
        if (hipGetDevice(&dev) != hipSuccess || hipDeviceGetAttribute(&cus, hipDeviceAttributeMultiprocessorCount, dev) != hipSuccess) { grid = -1; return; }
        if (hipFuncSetAttribute((const void*)fwd_kernel, hipFuncAttributeMaxDynamicSharedMemorySize, LDS_BYTES) != hipSuccess) { fprintf(stderr, "kernel_launch: hipFuncSetAttribute failed\n"); grid = -1; return; }
        if (hipOccupancyMaxActiveBlocksPerMultiprocessor(&per_cu, (const void*)fwd_kernel, NWAVES * 64, LDS_BYTES) != hipSuccess || per_cu < 1) { fprintf(stderr, "kernel_launch: occupancy query says %d\n", per_cu); per_cu = 1; }
        (void)hipGetLastError();
        grid = cus * (per_cu < 1 ? 1 : per_cu);
        fprintf(stderr, "kernel_launch: cus %d per_cu %d grid %d\n", cus, per_cu, grid);
    }
    if (grid < 0) return;
    Args a{};
    for (int i = 0; i < 15; ++i) a.in[i] = (const float*)d_in[i];
    a.out = (float*)d_out; a.ws = (unsigned char*)d_ws;
    if (MK_N_LAUNCHES == 1) {
        a.ph_lo = 0; a.ph_hi = 8; a.coop = 1;
        if (hipMemsetAsync((char*)d_ws + WS_BAR, 0, 16384, stream) != hipSuccess) { fprintf(stderr, "kernel_launch: memset failed\n"); return; }
        void* kargs[] = {&a};
        hipError_t e = hipLaunchCooperativeKernel((const void*)fwd_kernel, dim3(grid), dim3(NWAVES * 64), kargs, LDS_BYTES, stream);
        if (e != hipSuccess) fprintf(stderr, "kernel_launch: cooperative launch failed: %s (grid %d)\n", hipGetErrorString(e), grid);
#ifdef PROBE_RERUN_REST
        a.ph_lo = 1; e = hipLaunchCooperativeKernel((const void*)fwd_kernel, dim3(grid), dim3(NWAVES * 64), kargs, LDS_BYTES, stream);
#endif
    } else {
        for (int p = 0; p < 8; ++p) {
            a.ph_lo = p; a.ph_hi = p + 1; a.coop = 0;
            hipLaunchKernelGGL(fwd_kernel, dim3(grid), dim3(NWAVES * 64), LDS_BYTES, stream, a);
        }
    }
}
```
